# Optimizing an MI355X kernel written in HIP

```python
import math, functools
import jax, jax.numpy as jnp
from jax import lax
import numpy as np

D_MODEL = 4096
BATCH = 2
SEQ = 4096
DEPTH = 2
DEC_BATCH = 8
DEC_SEQ = 2048
PAST_LEN = 128

N_META = 16
GRID_W = 64
MIX_WIDTH = D_MODEL
GROUP_WIDTH = MIX_WIDTH // 4
D_FF = 4 * D_MODEL
EPS = 1e-6
CHUNK = 128

SSD_HEAD_DIM = 64
SSD_HEADS = GROUP_WIDTH // SSD_HEAD_DIM
SSD_GROUPS = 2
SSD_HPG = SSD_HEADS // SSD_GROUPS
SSD_STATE = 128
SSD_CONV_W = 5
D_INNER = GROUP_WIDTH
SSD_CONV_DIM = D_INNER + 2 * SSD_GROUPS * SSD_STATE
SSD_COLS = D_INNER + SSD_CONV_DIM + 2 * SSD_HEADS

SWA_HEAD_DIM = 128
SWA_HEADS = GROUP_WIDTH // SWA_HEAD_DIM
SWA_KV_HEADS = 2
SWA_WINDOW = 128
SWA_BLOCK = 128
SWA_COLS = (SWA_HEADS + 2 * SWA_KV_HEADS) * SWA_HEAD_DIM

NA_HEAD_DIM = 64
NA_HEADS = GROUP_WIDTH // NA_HEAD_DIM
NA_KH = 8
NA_KW = 16
NA_COLS = 3 * NA_HEADS * NA_HEAD_DIM

RET_HEADS = 8
RET_V_DIM = GROUP_WIDTH // RET_HEADS
RET_K_DIM = RET_V_DIM // 2
RET_COLS = 2 * RET_HEADS * RET_K_DIM + 2 * GROUP_WIDTH

IN_COLS = SSD_COLS + SWA_COLS + NA_COLS + RET_COLS

kernel_name = 'hybrid_bidir_encoder'


def rms_norm(x, w):
    xf = x.astype(jnp.float32)
    y = xf * lax.rsqrt(jnp.mean(xf * xf, axis=-1, keepdims=True) + EPS)
    return (y * w.astype(jnp.float32)).astype(x.dtype)


def chunk_decay_scan(q, k, v, log_a, include_diag):
    b, p = q.shape[:2]
    nc = p // CHUNK
    qc = q.reshape(b, nc, CHUNK, *q.shape[2:])
    kc = k.reshape(b, nc, CHUNK, *k.shape[2:])
    vc = v.reshape(b, nc, CHUNK, *v.shape[2:])
    acum = jnp.cumsum(log_a.astype(jnp.float32).reshape(b, nc, CHUNK, *log_a.shape[2:]), axis=2)
    mask = np.tril(np.ones((CHUNK, CHUNK), dtype=bool), k=0 if include_diag else -1)
    seg = jnp.where(mask[None, None, :, :, None, None],
                    acum[:, :, :, None] - acum[:, :, None, :], -jnp.inf)
    scores = jnp.einsum('bclgn,bcsgn->bclsg', qc, kc)
    y_intra = jnp.einsum('bclsgh,bcsghp->bclghp', scores[..., None] * jnp.exp(seg), vc)
    to_end = jnp.exp(acum[:, :, -1:] - acum)
    states = jnp.einsum('bcsgn,bcsghp->bcghnp', kc, vc * to_end[..., None])
    chunk_decay = jnp.exp(acum[:, :, -1])

    def step(carry, inp):
        st, dec = inp
        return carry * dec[..., None, None] + st, carry

    _, prev = lax.scan(step, jnp.zeros_like(states[:, 0]),
                       (jnp.swapaxes(states, 0, 1), jnp.swapaxes(chunk_decay, 0, 1)))
    prev = jnp.swapaxes(prev, 0, 1)
    y_inter = jnp.einsum('bclgn,bcghnp->bclghp', qc, prev) * jnp.exp(acum)[..., None]
    return (y_intra + y_inter).reshape(v.shape).astype(v.dtype)


def bidir_decay_scan(q, k, v_f, v_b, la_f, la_b):
    pad = CHUNK - N_META

    def front(a):
        return jnp.pad(a, [(0, 0), (pad, 0)] + [(0, 0)] * (a.ndim - 2))

    def rev(a):
        return jnp.flip(a, axis=1)

    qp, kp = front(q), front(k)
    fwd = chunk_decay_scan(qp, kp, front(v_f), front(la_f), True)
    bwd = rev(chunk_decay_scan(rev(qp), rev(kp), rev(front(v_b)), rev(front(la_b)), False))
    return (fwd + bwd)[:, pad:]


def centred_depthwise_conv(x, w, b):
    half = (SSD_CONV_W - 1) // 2
    y = lax.conv_general_dilated(x, w[:, None, :].astype(x.dtype), window_strides=(1,),
                                 padding=[(half, half)], dimension_numbers=('NWC', 'WIO', 'NWC'),
                                 feature_group_count=x.shape[-1])
    return y + b.astype(x.dtype)


def ssd_mixer(p, conv_w, conv_b, dt_bias, a_log, d_skip, norm_w):
    bsz, L = p.shape[:2]
    z, xbc, dt = jnp.split(p, [D_INNER, D_INNER + SSD_CONV_DIM], axis=-1)
    xbc = jax.nn.silu(centred_depthwise_conv(xbc, conv_w, conv_b))
    xs, bm, cm = jnp.split(xbc, [D_INNER, D_INNER + SSD_GROUPS * SSD_STATE], axis=-1)
    xs = xs.reshape(bsz, L, SSD_GROUPS, SSD_HPG, SSD_HEAD_DIM)
    bm = bm.reshape(bsz, L, SSD_GROUPS, SSD_STATE)
    cm = cm.reshape(bsz, L, SSD_GROUPS, SSD_STATE)
    dt = jax.nn.softplus(dt.astype(jnp.float32) + dt_bias.reshape(-1).astype(jnp.float32))
    dt = dt.reshape(bsz, L, 2, SSD_GROUPS, SSD_HPG)
    la = dt * (-jnp.exp(a_log.astype(jnp.float32))).reshape(2, SSD_GROUPS, SSD_HPG)
    v = xs[:, :, None] * dt[..., None]
    y = bidir_decay_scan(cm, bm, v[:, :, 0], v[:, :, 1], la[:, :, 0], la[:, :, 1])
    y = y + xs * d_skip.reshape(SSD_GROUPS, SSD_HPG, 1)
    y = y.reshape(bsz, L, D_INNER).astype(jnp.float32) * jax.nn.silu(z.astype(jnp.float32))
    yg = y.reshape(bsz, L, SSD_GROUPS, D_INNER // SSD_GROUPS)
    yg = yg * lax.rsqrt(jnp.mean(yg * yg, axis=-1, keepdims=True) + EPS)
    return (yg.reshape(bsz, L, D_INNER) * norm_w.astype(jnp.float32)).astype(p.dtype)


def alibi_slopes(n):
    return (2.0 ** (-8.0 * np.arange(1, n + 1) / n)).astype(np.float32)


def swa_mixer(p, sink):
    bsz, L = p.shape[:2]
    t = L - N_META
    g, r, dh, blk = SWA_KV_HEADS, SWA_HEADS // SWA_KV_HEADS, SWA_HEAD_DIM, SWA_BLOCK
    nb = t // blk
    scale = dh ** -0.5
    q, k, v = jnp.split(p, [SWA_HEADS * dh, (SWA_HEADS + g) * dh], axis=-1)
    q = q.reshape(bsz, L, g, r, dh)
    k = k.reshape(bsz, L, g, dh)
    v = v.reshape(bsz, L, g, dh)
    qm, qr = q[:, :N_META], q[:, N_META:]
    km, kr = k[:, :N_META], k[:, N_META:]
    vm, vr = v[:, :N_META], v[:, N_META:]
    slopes = alibi_slopes(SWA_HEADS).reshape(g, r)
    sink = sink.astype(jnp.float32).reshape(g, r)

    qb = qr.reshape(bsz, nb, blk, g, r, dh)

    def band(a):
        ap = jnp.pad(a, ((0, 0), (blk, blk), (0, 0), (0, 0)))
        return jnp.concatenate([ap[:, j * blk: j * blk + t].reshape(bsz, nb, blk, g, dh) for j in range(3)], axis=2)

    kb, vb = band(kr), band(vr)
    rel = np.arange(3 * blk)[None, :] - blk - np.arange(blk)[:, None]
    dist = np.abs(rel).astype(np.float32)
    key_pos = np.arange(nb)[:, None] * blk - blk + np.arange(3 * blk)[None, :]
    valid = (np.abs(rel) <= SWA_WINDOW)[None] & ((key_pos >= 0) & (key_pos < t))[:, None, :]
    s_band = (jnp.einsum('bnqgrd,bnkgd->bngrqk', qb, kb).astype(jnp.float32) * scale
              - slopes[:, :, None, None] * dist)
    s_band = jnp.where(valid[None, :, None, None], s_band, -jnp.inf)
    s_meta = jnp.einsum('bnqgrd,bmgd->bngrqm', qb, km).astype(jnp.float32) * scale
    s_sink = jnp.broadcast_to(sink[None, None, :, :, None, None], s_meta.shape[:-1] + (1,))
    probs = jax.nn.softmax(jnp.concatenate([s_band, s_meta, s_sink], axis=-1), axis=-1)
    o_real = (jnp.einsum('bngrqk,bnkgd->bnqgrd', probs[..., :3 * blk], vb)
              + jnp.einsum('bngrqm,bmgd->bnqgrd', probs[..., 3 * blk:3 * blk + N_META], vm))
    o_real = o_real.reshape(bsz, t, SWA_HEADS * dh)

    k0, v0 = kr[:, :blk], vr[:, :blk]
    mdist = N_META + np.arange(blk)[None, :] - np.arange(N_META)[:, None]
    sm_real = (jnp.einsum('bqgrd,bkgd->bgrqk', qm, k0).astype(jnp.float32) * scale
               - slopes[:, :, None, None] * mdist.astype(np.float32))
    sm_real = jnp.where((mdist <= SWA_WINDOW)[None, None, None], sm_real, -jnp.inf)
    sm_meta = jnp.einsum('bqgrd,bmgd->bgrqm', qm, km).astype(jnp.float32) * scale
    sm_sink = jnp.broadcast_to(sink[None, :, :, None, None], sm_meta.shape[:-1] + (1,))
    pm = jax.nn.softmax(jnp.concatenate([sm_real, sm_meta, sm_sink], axis=-1), axis=-1)
    o_meta = (jnp.einsum('bgrqk,bkgd->bqgrd', pm[..., :blk], v0)
              + jnp.einsum('bgrqm,bmgd->bqgrd', pm[..., blk:blk + N_META], vm))
    o_meta = o_meta.reshape(bsz, N_META, SWA_HEADS * dh)
    return jnp.concatenate([o_meta, o_real], axis=1).astype(p.dtype)


def na_mixer(p, rpb):
    bsz, L = p.shape[:2]
    t = L - N_META
    h, dh = NA_HEADS, NA_HEAD_DIM
    rows = t // GRID_W
    kh = min(NA_KH, rows)
    scale = dh ** -0.5
    q, k, v = [a.reshape(bsz, L, h, dh) for a in jnp.split(p, 3, axis=-1)]
    qm, km, vm = q[:, :N_META], k[:, :N_META], v[:, :N_META]
    qg = q[:, N_META:].reshape(bsz, rows, GRID_W, h, dh)
    kg = k[:, N_META:].reshape(bsz, rows, GRID_W, h, dh)
    vg = v[:, N_META:].reshape(bsz, rows, GRID_W, h, dh)
    col_start = np.clip(np.arange(GRID_W) - NA_KW // 2, 0, GRID_W - NA_KW)
    col_idx = col_start[:, None] + np.arange(NA_KW)[None, :]
    col_off = col_idx - np.arange(GRID_W)[:, None] + NA_KW - 1
    rpb = rpb.astype(jnp.float32)

    def row_block(r):
        q_r = lax.dynamic_index_in_dim(qg, r, axis=1, keepdims=False)
        r0 = jnp.clip(r - kh // 2, 0, rows - kh)
        k_sel = lax.dynamic_slice_in_dim(kg, r0, kh, axis=1)[:, :, col_idx]
        v_sel = lax.dynamic_slice_in_dim(vg, r0, kh, axis=1)[:, :, col_idx]
        s = jnp.einsum('bchd,bkcwhd->bhckw', q_r, k_sel).astype(jnp.float32) * scale
        row_off = r0 + jnp.arange(kh) - r + NA_KH - 1
        bias = rpb[:, row_off[:, None, None], col_off[None, :, :]]
        s = s + jnp.transpose(bias, (0, 2, 1, 3))[None]
        s_m = jnp.einsum('bchd,bmhd->bhcm', q_r, km).astype(jnp.float32) * scale
        probs = jax.nn.softmax(jnp.concatenate([s.reshape(bsz, h, GRID_W, kh * NA_KW), s_m], axis=-1), axis=-1)
        pw = probs[..., :kh * NA_KW].reshape(bsz, h, GRID_W, kh, NA_KW)
        o = (jnp.einsum('bhckw,bkcwhd->bchd', pw, v_sel)
             + jnp.einsum('bhcm,bmhd->bchd', probs[..., kh * NA_KW:], vm))
        return o.astype(p.dtype)

    o_real = lax.map(row_block, jnp.arange(rows))
    o_real = jnp.moveaxis(o_real, 0, 1).reshape(bsz, t, h * dh)

    kw0 = kg[:, :kh, :NA_KW].reshape(bsz, kh * NA_KW, h, dh)
    vw0 = vg[:, :kh, :NA_KW].reshape(bsz, kh * NA_KW, h, dh)
    s_w = jnp.einsum('bqhd,bkhd->bhqk', qm, kw0).astype(jnp.float32) * scale
    s_mm = jnp.einsum('bqhd,bmhd->bhqm', qm, km).astype(jnp.float32) * scale
    pm = jax.nn.softmax(jnp.concatenate([s_w, s_mm], axis=-1), axis=-1)
    o_meta = (jnp.einsum('bhqk,bkhd->bqhd', pm[..., :kh * NA_KW], vw0)
              + jnp.einsum('bhqm,bmhd->bqhd', pm[..., kh * NA_KW:], vm))
    o_meta = o_meta.reshape(bsz, N_META, h * dh)
    return jnp.concatenate([o_meta, o_real], axis=1).astype(p.dtype)


def retention_mixer(p, decay_logit):
    bsz, L = p.shape[:2]
    qk = RET_HEADS * RET_K_DIM
    q, k, v, gate = jnp.split(p, [qk, 2 * qk, 2 * qk + GROUP_WIDTH], axis=-1)
    q = q.reshape(bsz, L, RET_HEADS, RET_K_DIM)
    k = k.reshape(bsz, L, RET_HEADS, RET_K_DIM) * (RET_K_DIM ** -0.5)
    v = v.reshape(bsz, L, RET_HEADS, 1, RET_V_DIM)
    log_gamma = jax.nn.log_sigmoid(decay_logit.astype(jnp.float32))
    la_f = jnp.broadcast_to(log_gamma[0][:, None], (bsz, L, RET_HEADS, 1))
    la_b = jnp.broadcast_to(log_gamma[1][:, None], (bsz, L, RET_HEADS, 1))
    y = bidir_decay_scan(q, k, v, v, la_f, la_b)[:, :, :, 0].astype(jnp.float32)
    mu = jnp.mean(y, axis=-1, keepdims=True)
    var = jnp.mean(jnp.square(y - mu), axis=-1, keepdims=True)
    y = (y - mu) * lax.rsqrt(var + 1e-5)
    return (y.reshape(bsz, L, GROUP_WIDTH) * jax.nn.silu(gate.astype(jnp.float32))).astype(p.dtype)


def trunk(x, meta_tokens, norm1_w, w_in, ssd_conv_w, ssd_conv_b, ssd_dt_bias, ssd_a_log, ssd_d,
          ssd_norm_w, swa_sink, na_rpb, ret_decay, w_out, norm2_w, w_up, w_down, final_norm_w):
    bsz = x.shape[0]
    meta = jnp.broadcast_to(meta_tokens.astype(x.dtype)[None], (bsz, N_META, x.shape[-1]))
    h = jnp.concatenate([meta, x], axis=1)
    splits = [SSD_COLS, SSD_COLS + SWA_COLS, SSD_COLS + SWA_COLS + NA_COLS]
    for i in range(DEPTH):
        n = rms_norm(h, norm1_w[i])
        p_ssd, p_swa, p_na, p_ret = jnp.split(n @ w_in[i], splits, axis=-1)
        mixed = jnp.concatenate([
            ssd_mixer(p_ssd, ssd_conv_w[i], ssd_conv_b[i], ssd_dt_bias[i], ssd_a_log[i], ssd_d[i], ssd_norm_w[i]),
            swa_mixer(p_swa, swa_sink[i]),
            na_mixer(p_na, na_rpb[i]),
            retention_mixer(p_ret, ret_decay[i]),
        ], axis=-1)
        h = h + mixed @ w_out[i]
        n2 = rms_norm(h, norm2_w[i])
        h = h + jnp.square(jax.nn.relu(n2 @ w_up[i])) @ w_down[i]
    return rms_norm(h, final_norm_w)[:, N_META:]


def setup_inputs(seed: int = 0) -> dict:
    key = jax.random.key(seed)
    ks = jax.random.split(key, 20)
    nrm = jax.random.normal
    d = D_MODEL
    dt0 = jnp.exp(jax.random.uniform(ks[6], (DEPTH, 2, SSD_HEADS), minval=math.log(1e-3), maxval=math.log(1e-1)))
    dt_bias = dt0 + jnp.log(-jnp.expm1(-dt0))
    ret_init = np.log(2.0 ** (5 + np.arange(RET_HEADS)) - 1.0).astype(np.float32)
    return {
        'x_prompt': nrm(ks[0], (BATCH, SEQ, d), jnp.float32),
        'x_sample': nrm(ks[1], (DEC_BATCH, DEC_SEQ, d), jnp.float32),
        'meta_tokens': nrm(ks[2], (N_META, d), jnp.float32),
        'norm1_w': 1.0 + 0.02 * nrm(ks[3], (DEPTH, d), jnp.float32),
        'w_in': nrm(ks[4], (DEPTH, d, IN_COLS), jnp.float32) * d ** -0.5,
        'ssd_conv_w': nrm(ks[5], (DEPTH, SSD_CONV_W, SSD_CONV_DIM), jnp.float32) * SSD_CONV_W ** -0.5,
        'ssd_conv_b': 0.02 * nrm(ks[7], (DEPTH, SSD_CONV_DIM), jnp.float32),
        'ssd_dt_bias': dt_bias,
        'ssd_a_log': jnp.log(jax.random.uniform(ks[8], (DEPTH, 2, SSD_HEADS), minval=1.0, maxval=16.0)),
        'ssd_d': 1.0 + 0.1 * nrm(ks[9], (DEPTH, SSD_HEADS), jnp.float32),
        'ssd_norm_w': 1.0 + 0.02 * nrm(ks[10], (DEPTH, D_INNER), jnp.float32),
        'swa_sink': 0.5 * nrm(ks[11], (DEPTH, SWA_HEADS), jnp.float32),
        'na_rpb': 0.1 * nrm(ks[12], (DEPTH, NA_HEADS, 2 * NA_KH - 1, 2 * NA_KW - 1), jnp.float32),
        'ret_decay': jnp.asarray(ret_init) + 0.1 * nrm(ks[13], (DEPTH, 2, RET_HEADS), jnp.float32),
        'w_out': nrm(ks[14], (DEPTH, MIX_WIDTH, d), jnp.float32) * MIX_WIDTH ** -0.5,
        'norm2_w': 1.0 + 0.02 * nrm(ks[15], (DEPTH, d), jnp.float32),
        'w_up': nrm(ks[16], (DEPTH, d, D_FF), jnp.float32) * d ** -0.5,
        'w_down': nrm(ks[17], (DEPTH, D_FF, d), jnp.float32) * D_FF ** -0.5,
        'final_norm_w': 1.0 + 0.02 * nrm(ks[18], (d,), jnp.float32),
    }


def reference(x_prompt, x_sample, meta_tokens, norm1_w, w_in, ssd_conv_w, ssd_conv_b, ssd_dt_bias,
              ssd_a_log, ssd_d, ssd_norm_w, swa_sink, na_rpb, ret_decay, w_out, norm2_w, w_up, w_down,
              final_norm_w):
    run = functools.partial(
        trunk, meta_tokens=meta_tokens, norm1_w=norm1_w, w_in=w_in, ssd_conv_w=ssd_conv_w,
        ssd_conv_b=ssd_conv_b, ssd_dt_bias=ssd_dt_bias, ssd_a_log=ssd_a_log, ssd_d=ssd_d,
        ssd_norm_w=ssd_norm_w, swa_sink=swa_sink, na_rpb=na_rpb, ret_decay=ret_decay, w_out=w_out,
        norm2_w=norm2_w, w_up=w_up, w_down=w_down, final_norm_w=final_norm_w)
    y_prompt = run(x_prompt)
    y_sample = run(x_sample)
    return (y_prompt, y_sample)
```

```cpp
#include <hip/hip_runtime.h>
#include <cstdio>
#include <cstdint>

#ifndef N_LAUNCH_MODE
#define N_LAUNCH_MODE 1
#endif

constexpr int D = 4096, FF = 16384;
constexpr int NREAL = 24576, NSEQ = 10, NMETA = 16, MP = 24832;
constexpr int META0 = NREAL;
constexpr int NTOK = NREAL + NSEQ * NMETA;
constexpr int IN_N = 10496, P_LD = 10240;
constexpr int IN_SRC = 10272;
constexpr int PC_Z = 0, PC_XBC = 1024, PC_SWA = 2560, PC_NA = 4096, PC_RET = 7168;
constexpr float EPS = 1e-6f;

constexpr size_t MiB = 1u << 20;
constexpr size_t WS_CTL = 0, CTL_ZERO_BYTES = 65536;
constexpr size_t SZ_WIN = (size_t)IN_N * D * 2, SZ_WOUT = (size_t)D * D * 2, SZ_WUP = (size_t)FF * D * 2, SZ_WDN = (size_t)D * FF * 2;
constexpr size_t WS_WIN = 8 * MiB;
constexpr size_t WS_WOUT = WS_WIN + 2 * SZ_WIN;
constexpr size_t WS_WUP = WS_WOUT + 2 * SZ_WOUT;
constexpr size_t WS_WDN = WS_WUP + 2 * SZ_WUP;
constexpr size_t WS_HM = WS_WDN + 2 * SZ_WDN;
constexpr size_t WS_XN = WS_HM + (size_t)256 * D * 4;
constexpr size_t WS_HB = WS_XN + (size_t)MP * D * 2;
constexpr size_t WS_BIG = WS_HB + (size_t)MP * D * 2;
constexpr size_t WS_P = WS_BIG;
constexpr size_t WS_DT = WS_P + (size_t)MP * P_LD * 2;
constexpr size_t WS_DTL = WS_DT + (size_t)MP * 32 * 4;
constexpr size_t WS_XBC = WS_DTL + (size_t)MP * 64 * 4;
constexpr size_t WS_LOC = WS_XBC + (size_t)MP * 1536 * 2;
constexpr size_t WS_SIN = WS_LOC + (size_t)202 * 24 * 2 * 8192 * 2;
constexpr size_t WS_CDEC = WS_SIN + (size_t)202 * 24 * 2 * 8192 * 2;
constexpr size_t WS_BIG_END1 = WS_CDEC + (size_t)202 * 24 * 2 * 4;
constexpr size_t WS_HID = WS_BIG;
constexpr size_t WS_SLAB = WS_HID + (size_t)MP * FF * 2;
constexpr size_t WS_BIG_END2 = WS_SLAB + (size_t)16 * 256 * D * 4;
constexpr size_t WS_END = WS_BIG_END1 > WS_BIG_END2 ? WS_BIG_END1 : WS_BIG_END2;
static_assert(WS_END <= (size_t)2048 * MiB, "workspace map must fit 2 GiB");

constexpr int CW_BAR = 4096;
constexpr size_t WS_RSTD = 65536;
constexpr size_t WS_SSP = WS_RSTD + (size_t)4 * MP * 4;
static_assert(WS_SSP + (size_t)MP * 64 * 4 <= 8 * MiB, "control region");

constexpr int RING_OFF = 0, RING_BYTES = 131072;
constexpr int LDSCTL_OFF = RING_BYTES, MISC_OFF = LDSCTL_OFF + 320;
constexpr int LDS_BYTES = 147456;
constexpr int NWAVES = 8, NTHREADS = 512;

#define GAS __attribute__((address_space(1)))
#define LAS __attribute__((address_space(3)))
typedef unsigned short bf16;
typedef unsigned v4u __attribute__((ext_vector_type(4)));
typedef unsigned v2u __attribute__((ext_vector_type(2)));
typedef float f32x4 __attribute__((ext_vector_type(4)));
typedef float f32x2 __attribute__((ext_vector_type(2)));
typedef short bf16x8 __attribute__((ext_vector_type(8)));

__device__ __forceinline__ unsigned pk2(float lo, float hi) { unsigned r; asm("v_cvt_pk_bf16_f32 %0, %1, %2" : "=v"(r) : "v"(lo), "v"(hi)); return r; }
__device__ __forceinline__ unsigned f2bf(float f) { return pk2(f, 0.f) & 0xffffu; }
__device__ __forceinline__ float bflo(unsigned w) { return __builtin_bit_cast(float, w << 16); }
__device__ __forceinline__ float bfhi(unsigned w) { return __builtin_bit_cast(float, w & 0xffff0000u); }
__device__ __forceinline__ float bf1(bf16 b) { return __builtin_bit_cast(float, (unsigned)b << 16); }
__device__ __forceinline__ void unpack8(const v4u w, float (&f)[8]) {
    f[0] = bflo(w.x); f[1] = bfhi(w.x); f[2] = bflo(w.y); f[3] = bfhi(w.y); f[4] = bflo(w.z); f[5] = bfhi(w.z); f[6] = bflo(w.w); f[7] = bfhi(w.w);
}
__device__ __forceinline__ float siluf(float x) { return x * __builtin_amdgcn_rcpf(1.f + __expf(-x)); }
__device__ __forceinline__ float wave_sum(float v) {
#pragma unroll
    for (int o = 1; o < 64; o <<= 1) v += __shfl_xor(v, o);
    return v;
}
#define LDS_WAIT() asm volatile("s_waitcnt lgkmcnt(0)" ::: "memory")

__device__ __forceinline__ int seq_start(int s) { return s < 2 ? s * 4096 : 8192 + (s - 2) * 2048; }
__device__ __forceinline__ int seq_T(int s) { return s < 2 ? 4096 : 2048; }
__device__ __forceinline__ int seq_of_real(int r) { return r < 8192 ? (r >> 12) : 2 + ((r - 8192) >> 11); }
__device__ __forceinline__ int row_of(int s, int l) { return l < NMETA ? META0 + s * NMETA + l : seq_start(s) + l - NMETA; }

__device__ __forceinline__ int opaque_lane() { int t; asm volatile("v_mbcnt_lo_u32_b32 %0, -1, 0\n\tv_mbcnt_hi_u32_b32 %0, -1, %0" : "=v"(t)); return t; }
__device__ __forceinline__ int opaque_tid(int wave_s) { return (wave_s << 6) | opaque_lane(); }
namespace pg8 {
#define PG8_LAS __attribute__((address_space(3)))
typedef unsigned short bf16_t;
typedef short bf16x8 __attribute__((ext_vector_type(8)));
typedef float f32x4 __attribute__((ext_vector_type(4)));
typedef unsigned u32x4 __attribute__((ext_vector_type(4)));
constexpr int BM = 256, BK = 64, HALF = 128, HTB = HALF * BK * 2, STAGE_BYTES = 8 * HTB, NXCD = 8, WGM = 8;

__host__ __device__ __forceinline__ int lds_byte(int r, int c) { const int st = (r >> 4) * 2 + (c >> 5), rr = r & 15, cc = c & 31, ob = rr * 64 + cc * 2; return st * 1024 + (ob ^ (((ob >> 9) & 1) << 5)); }
__host__ __device__ __forceinline__ void stage_rc(int b, int& R, int& C) { const int st = b / 1024, sb = b % 1024, swz = sb ^ (((sb >> 9) & 1) << 5); R = (st >> 1) * 16 + swz / 64; C = (st & 1) * 32 + (swz % 64) / 2; }
__host__ __device__ __forceinline__ int perm32(int rho) { const int n = rho >> 4, i = rho & 15; return 8 * (i >> 2) + 4 * n + (i & 3); }

struct Unit { int pm, pn, kt0, nkt; };
struct Gemm { const bf16_t* A; const bf16_t* Bt; int M, N, K; };

struct StaticOrder {
    int nM, nN, nwg, G, c, nt, split;
    __host__ __device__ void init(int N, int K, int split_, int G_, int c_) { nM = 96; nN = N / BM; nwg = nM * nN; G = G_; c = c_; nt = K / BK; split = split_; }
    __host__ __device__ bool next(int i, Unit& u) const {
        const int L = i * G + c;
        if (L >= nwg + nN * split) return false;
        const bool ex = L >= nwg;
        const int e = ex ? L - nwg : 0;
        int wgid = ex ? 0 : L; { const int q = nwg / NXCD, r = nwg % NXCD, xcd = wgid % NXCD, off = wgid / NXCD; wgid = (xcd < r ? xcd * (q + 1) : r * (q + 1) + (xcd - r) * q) + off; }
        const int nig = WGM * nN, gid = wgid / nig, fm = gid * WGM, gsz = (nM - fm) < WGM ? (nM - fm) : WGM;
        int pm_m = fm + ((wgid % nig) % gsz), pn_m = (wgid % nig) / gsz;
        if (nN == 16 && G == 256) {
            const int xcd = c & 7, j = c >> 3; pm_m = 8 * (2 * i + (xcd >> 2)) + (j & 7); pn_m = 4 * (xcd & 3) + (j >> 3); }
        if (nN == 64 && G == 256) {
            const int xcd = c & 7, j = c >> 3; pm_m = 4 * i + (j & 3); pn_m = 8 * xcd + (j >> 2); }
        const int nk_e = nt / split;
        u.pm = ex ? 96 : pm_m; u.pn = ex ? e / split : pn_m; u.nkt = ex ? nk_e : nt; u.kt0 = ex ? (e % split) * nk_e : 0;
        return true;
    }
    __device__ __forceinline__ void a_ready(const Unit&) const {}
    __device__ __forceinline__ void done(const Unit&) const {}
};

__device__ __forceinline__ unsigned cvt_pk_bf16(float lo, float hi) { unsigned r; asm volatile("v_cvt_pk_bf16_f32 %0, %1, %2" : "=v"(r) : "v"(lo), "v"(hi)); return r; }


struct EpiInProj {
    static constexpr bool PERM = true, AFTER_DRAIN = false;
    bf16_t* P; float* DT; const float* rstd;
    static constexpr bool NEED_RS = true;
    __device__ __forceinline__ void operator()(const f32x4 (&acc)[2][2][4][2], const Unit& u, int wr, int wc, const PG8_LAS float* rsl, int) const {
        const int ln = opaque_lane(), fr = ln & 15, fq = ln >> 4;
        const int row0 = u.pm * BM + wr * 64 + fr;
        float rs[2][4];
#pragma unroll
        for (int ai = 0; ai < 2; ++ai)
#pragma unroll
            for (int m = 0; m < 4; ++m) rs[ai][m] = rsl[wr * 64 + fr + ai * HALF + m * 16];
        if (u.pn < 40) {
            const int col0 = u.pn * BM + wc * 32 + 8 * fq;
#pragma unroll
            for (int ai = 0; ai < 2; ++ai)
#pragma unroll
                for (int m = 0; m < 4; ++m) { bf16_t* rowp = P + (size_t)(row0 + ai * HALF + m * 16) * P_LD + col0;
#pragma unroll
                    for (int bj = 0; bj < 2; ++bj) { const f32x4 v0 = acc[ai][bj][m][0] * rs[ai][m], v1 = acc[ai][bj][m][1] * rs[ai][m];
                        u32x4 w; w.x = cvt_pk_bf16(v0[0], v0[1]); w.y = cvt_pk_bf16(v0[2], v0[3]); w.z = cvt_pk_bf16(v1[0], v1[1]); w.w = cvt_pk_bf16(v1[2], v1[3]);
                        *(u32x4*)(rowp + bj * HALF) = w; } }
        } else if (wc == 0) {
#pragma unroll
            for (int ai = 0; ai < 2; ++ai)
#pragma unroll
                for (int m = 0; m < 4; ++m) { float* rowp = DT + (size_t)(row0 + ai * HALF + m * 16) * 32 + 8 * fq;
                    *(f32x4*)(rowp) = acc[ai][0][m][0] * rs[ai][m]; *(f32x4*)(rowp + 4) = acc[ai][0][m][1] * rs[ai][m]; }
        }
    }
};
struct EpiResid {
    static constexpr bool PERM = true, AFTER_DRAIN = false;
    bf16_t* HB; float* slab; int fullkt; float* ssp; const float* rstd;
    static constexpr bool NEED_RS = false;
    __device__ __forceinline__ void operator()(const f32x4 (&acc)[2][2][4][2], const Unit& u, int wr, int wc, const PG8_LAS float*, int) const {
        const int ln = opaque_lane(), fr = ln & 15, fq = ln >> 4;
        const int rloc = wr * 64 + fr, col0 = u.pn * BM + wc * 32 + 8 * fq;
        if (u.nkt == fullkt) {
            u32x4 old[2][4][2];
#pragma unroll
            for (int ai = 0; ai < 2; ++ai)
#pragma unroll
                for (int m = 0; m < 4; ++m) { const bf16_t* hp = HB + (size_t)(u.pm * BM + rloc + ai * HALF + m * 16) * D + col0;
#pragma unroll
                    for (int bj = 0; bj < 2; ++bj) old[ai][m][bj] = *(const u32x4*)(hp + bj * HALF); }
#pragma unroll
            for (int ai = 0; ai < 2; ++ai)
#pragma unroll
                for (int m = 0; m < 4; ++m) { const int row = u.pm * BM + rloc + ai * HALF + m * 16; bf16_t* hp = HB + (size_t)row * D + col0; float sq = 0.f;
#pragma unroll
                    for (int bj = 0; bj < 2; ++bj) { const u32x4 o = old[ai][m][bj];
                        f32x4 v0 = acc[ai][bj][m][0], v1 = acc[ai][bj][m][1];
                        v0[0] += __builtin_bit_cast(float, o.x << 16); v0[1] += __builtin_bit_cast(float, o.x & 0xffff0000u); v0[2] += __builtin_bit_cast(float, o.y << 16); v0[3] += __builtin_bit_cast(float, o.y & 0xffff0000u);
                        v1[0] += __builtin_bit_cast(float, o.z << 16); v1[1] += __builtin_bit_cast(float, o.z & 0xffff0000u); v1[2] += __builtin_bit_cast(float, o.w << 16); v1[3] += __builtin_bit_cast(float, o.w & 0xffff0000u);
                        sq += ((v0[0] * v0[0] + v0[1] * v0[1]) + (v0[2] * v0[2] + v0[3] * v0[3])) + ((v1[0] * v1[0] + v1[1] * v1[1]) + (v1[2] * v1[2] + v1[3] * v1[3]));
                        u32x4 w; w.x = cvt_pk_bf16(v0[0], v0[1]); w.y = cvt_pk_bf16(v0[2], v0[3]); w.z = cvt_pk_bf16(v1[0], v1[1]); w.w = cvt_pk_bf16(v1[2], v1[3]);
                        *(u32x4*)(hp + bj * HALF) = w; }
                    sq += __shfl_xor(sq, 16); sq += __shfl_xor(sq, 32);
                    if (fq == 0) ssp[(size_t)row * 64 + u.pn * 4 + wc] = sq; }
        } else {
            const int ks = u.kt0 / u.nkt;
#pragma unroll
            for (int ai = 0; ai < 2; ++ai)
#pragma unroll
                for (int m = 0; m < 4; ++m) { float* rowp = slab + ((size_t)ks * 256 + rloc + ai * HALF + m * 16) * D + col0;
#pragma unroll
                    for (int bj = 0; bj < 2; ++bj) { *(f32x4*)(rowp + bj * HALF) = acc[ai][bj][m][0]; *(f32x4*)(rowp + bj * HALF + 4) = acc[ai][bj][m][1]; } }
        }
    }
};
struct EpiUp {
    static constexpr bool PERM = true, AFTER_DRAIN = false;
    bf16_t* O; const float* rstd;
    static constexpr bool NEED_RS = true;
    __device__ __forceinline__ void operator()(const f32x4 (&acc)[2][2][4][2], const Unit& u, int wr, int wc, const PG8_LAS float* rsl, int) const {
        const int ln = opaque_lane(), fr = ln & 15, fq = ln >> 4;
        const int row0 = u.pm * BM + wr * 64 + fr, col0 = u.pn * BM + wc * 32 + 8 * fq;
#pragma unroll
        for (int ai = 0; ai < 2; ++ai)
#pragma unroll
            for (int m = 0; m < 4; ++m) { bf16_t* rowp = O + (size_t)(row0 + ai * HALF + m * 16) * FF + col0;
                const float rs = rsl[wr * 64 + fr + ai * HALF + m * 16];
#pragma unroll
                for (int bj = 0; bj < 2; ++bj) { f32x4 v0 = acc[ai][bj][m][0] * rs, v1 = acc[ai][bj][m][1] * rs;
                    v0 = __builtin_elementwise_max(v0, (f32x4){0.f, 0.f, 0.f, 0.f}); v1 = __builtin_elementwise_max(v1, (f32x4){0.f, 0.f, 0.f, 0.f}); v0 = v0 * v0; v1 = v1 * v1;
                    u32x4 w; w.x = cvt_pk_bf16(v0[0], v0[1]); w.y = cvt_pk_bf16(v0[2], v0[3]); w.z = cvt_pk_bf16(v1[0], v1[1]); w.w = cvt_pk_bf16(v1[2], v1[3]);
                    *(u32x4*)(rowp + bj * HALF) = w; } }
    }
};

template <class Epi, class Sched, bool ALIGN_EPI = false, bool SP2 = false>
__device__ __forceinline__ void gemm_phase(PG8_LAS unsigned char* lds, const Gemm g, const Sched& S, const Epi& E, int wave_s) {
    const int tid = opaque_tid(wave_s), wid = __builtin_amdgcn_readfirstlane(tid >> 6), lane = tid & 63, wr = wid >> 2, wc = wid & 3, fr = lane & 15, fq = lane >> 4;
    const int K = g.K;
    unsigned voffA[2], voffB[2];
#pragma unroll
    for (int i = 0; i < 2; ++i) { int R, C; stage_rc(tid * 16 + i * 8192, R, C); const int Rb = Epi::PERM ? ((R & ~31) + perm32(R & 31)) : R;
        voffA[i] = (unsigned)(R * K + C) * 2u; voffB[i] = (unsigned)(Rb * K + C) * 2u; }
    const size_t kstep = (size_t)(BK * 2);
    const size_t hstep = (size_t)HALF * K * 2;
    const size_t tstep = 2 * hstep;
    const unsigned ldsw = (unsigned)wid * 1024u;
    const int aoff = lds_byte(wr * 64 + fr, fq * 8), boff = lds_byte(wc * 32 + fr, fq * 8);
#define PG8_SA(b, h) (((b) * 2 + (h)) * HTB)
#define PG8_SB(b, h) ((4 + (b) * 2 + (h)) * HTB)
#define PG8_STAGE(bufoff, gbase, voff) do { _Pragma("unroll") for (int _i = 0; _i < 2; ++_i) \
        __builtin_amdgcn_global_load_lds((const unsigned*)((const char*)(gbase) + (voff)[_i]), (PG8_LAS unsigned*)(lds + (bufoff) + ldsw + _i * 8192), 16, 0, 0); } while (0)
#define PG8_LDA(dst, b, h) do { _Pragma("unroll") for (int m = 0; m < 4; ++m) _Pragma("unroll") for (int k = 0; k < 2; ++k) dst[m][k] = *(const PG8_LAS bf16x8*)(lds + PG8_SA(b, h) + aoff + m * 2048 + k * 1024); } while (0)
#define PG8_LDB(dst, b, h) do { _Pragma("unroll") for (int n = 0; n < 2; ++n) _Pragma("unroll") for (int k = 0; k < 2; ++k) dst[n][k] = *(const PG8_LAS bf16x8*)(lds + PG8_SB(b, h) + boff + n * 2048 + k * 1024); } while (0)
#define PG8_MMA(ai, bj, At, Bt) do { __builtin_amdgcn_s_setprio(1); _Pragma("unroll") for (int m = 0; m < 4; ++m) _Pragma("unroll") for (int n = 0; n < 2; ++n) _Pragma("unroll") for (int k = 0; k < 2; ++k) \
        acc[ai][bj][m][n] = __builtin_amdgcn_mfma_f32_16x16x32_bf16(Bt[n][k], At[m][k], acc[ai][bj][m][n], 0, 0, 0); __builtin_amdgcn_s_setprio(0); } while (0)
#define PG8_WAIT_V(n) asm volatile("s_waitcnt vmcnt(" #n ")" ::: "memory")
#define PG8_WAIT_L(n) asm volatile("s_waitcnt lgkmcnt(" #n ")" ::: "memory")
#define PG8_BAR __builtin_amdgcn_s_barrier()
#define PG8_SCHED __builtin_amdgcn_sched_barrier(0)
    Unit cur, nxt; int ui = 0;
    if (!S.next(0, cur)) return;
    f32x4 acc[2][2][4][2];
#pragma unroll
    for (int a = 0; a < 2; ++a)
#pragma unroll
        for (int b = 0; b < 2; ++b)
#pragma unroll
            for (int m = 0; m < 4; ++m)
#pragma unroll
                for (int n = 0; n < 2; ++n) acc[a][b][m][n] = (f32x4){0.f, 0.f, 0.f, 0.f};
    bf16x8 At[4][2], B0[2][2], B1[2][2];
    const char* cA = (const char*)g.A + (size_t)cur.pm * tstep + (size_t)cur.kt0 * kstep; const char* cB = (const char*)g.Bt + (size_t)cur.pn * tstep + (size_t)cur.kt0 * kstep;
    S.a_ready(cur);
    if constexpr (SP2) {
        PG8_STAGE(PG8_SB(0, 0), cB, voffB); PG8_STAGE(PG8_SB(0, 1), cB + hstep, voffB); PG8_STAGE(PG8_SA(0, 0), cA, voffA); PG8_STAGE(PG8_SA(0, 1), cA + hstep, voffA);
        if (wr == 1) PG8_BAR;
        PG8_WAIT_V(2); PG8_BAR;
        PG8_STAGE(PG8_SB(1, 0), cB + kstep, voffB); PG8_STAGE(PG8_SA(1, 0), cA + kstep, voffA); PG8_STAGE(PG8_SB(1, 1), cB + hstep + kstep, voffB);
        PG8_WAIT_V(6); PG8_BAR;
    } else {
        PG8_STAGE(PG8_SB(0, 0), cB, voffB); PG8_STAGE(PG8_SA(0, 0), cA, voffA); PG8_STAGE(PG8_SB(0, 1), cB + hstep, voffB); PG8_STAGE(PG8_SA(0, 1), cA + hstep, voffA);
        if (wr == 1) PG8_BAR;
        PG8_WAIT_V(4); PG8_BAR;
        PG8_STAGE(PG8_SB(1, 0), cB + kstep, voffB); PG8_STAGE(PG8_SA(1, 0), cA + kstep, voffA); PG8_STAGE(PG8_SB(1, 1), cB + hstep + kstep, voffB);
        PG8_WAIT_V(6); PG8_BAR;
    }
    for (;;) {
        const bool has_next = S.next(ui + 1, nxt);
        const char* nA = has_next ? (const char*)g.A + (size_t)nxt.pm * tstep + (size_t)nxt.kt0 * kstep : cA; const char* nB = has_next ? (const char*)g.Bt + (size_t)nxt.pn * tstep + (size_t)nxt.kt0 * kstep : cB;
        const int nt = cur.nkt;
        PG8_LAS float* rsl = (PG8_LAS float*)(lds + STAGE_BYTES + 2048 + (ui & 1) * 1024);
        for (int t = 0; t < nt; t += 2) {
            const bool last = (t == nt - 2);
            if constexpr (Epi::NEED_RS) { if (t == 0 && wid < 4) __builtin_amdgcn_global_load_lds((const unsigned*)(E.rstd + cur.pm * BM + wid * 64 + lane), (PG8_LAS unsigned*)(rsl + wid * 64), 4, 0, 0); }
            const char* a1 = cA + (size_t)(t + 1) * kstep;
            const char* a2 = last ? nA : cA + (size_t)(t + 2) * kstep; const char* b2 = last ? nB : cB + (size_t)(t + 2) * kstep;
            const char* a3 = a2 + kstep; const char* b3 = b2 + kstep;
            if (last && has_next) S.a_ready(nxt);
            if constexpr (SP2) {
            PG8_LDB(B0, 0, 0); PG8_LDB(B1, 0, 1); PG8_SCHED; PG8_LDA(At, 0, 0); PG8_STAGE(PG8_SA(1, 1), a1 + hstep, voffA);
            PG8_WAIT_V(8); PG8_WAIT_L(0); PG8_BAR; PG8_MMA(0, 0, At, B0); PG8_MMA(0, 1, At, B1); PG8_BAR; PG8_SCHED;
            PG8_LDA(At, 0, 1); PG8_STAGE(PG8_SB(0, 0), b2, voffB); PG8_STAGE(PG8_SB(0, 1), b2 + hstep, voffB); PG8_STAGE(PG8_SA(0, 0), a2, voffA);
            PG8_WAIT_V(8); PG8_WAIT_L(0); PG8_BAR; PG8_MMA(1, 0, At, B0); PG8_MMA(1, 1, At, B1); PG8_BAR; PG8_SCHED;
            PG8_LDB(B0, 1, 0); PG8_LDB(B1, 1, 1); PG8_SCHED; PG8_LDA(At, 1, 0); PG8_STAGE(PG8_SA(0, 1), a2 + hstep, voffA);
            PG8_WAIT_V(8); PG8_WAIT_L(0); PG8_BAR; PG8_MMA(0, 0, At, B0); PG8_MMA(0, 1, At, B1); PG8_BAR; PG8_SCHED;
            PG8_LDA(At, 1, 1); PG8_STAGE(PG8_SB(1, 0), b3, voffB); PG8_STAGE(PG8_SB(1, 1), b3 + hstep, voffB); PG8_STAGE(PG8_SA(1, 0), a3, voffA);
            PG8_WAIT_V(8); PG8_WAIT_L(0); PG8_BAR; PG8_MMA(1, 0, At, B0); PG8_MMA(1, 1, At, B1); PG8_BAR; PG8_SCHED;
            } else {
            PG8_LDB(B0, 0, 0); PG8_SCHED; PG8_LDA(At, 0, 0); PG8_STAGE(PG8_SA(1, 1), a1 + hstep, voffA);
            PG8_WAIT_L(8); PG8_BAR; PG8_WAIT_L(0); PG8_MMA(0, 0, At, B0); PG8_BAR; PG8_SCHED;
            PG8_LDB(B1, 0, 1); PG8_STAGE(PG8_SB(0, 0), b2, voffB);
            PG8_BAR; PG8_WAIT_L(0); PG8_MMA(0, 1, At, B1); PG8_BAR;
            PG8_LDA(At, 0, 1); PG8_STAGE(PG8_SA(0, 0), a2, voffA);
            PG8_BAR; PG8_WAIT_L(0); PG8_MMA(1, 0, At, B0); PG8_BAR; PG8_SCHED;
            PG8_STAGE(PG8_SB(0, 1), b2 + hstep, voffB);
            PG8_WAIT_V(6); PG8_BAR; PG8_MMA(1, 1, At, B1); PG8_BAR;
            PG8_LDB(B0, 1, 0); PG8_SCHED; PG8_LDA(At, 1, 0); PG8_STAGE(PG8_SA(0, 1), a2 + hstep, voffA);
            PG8_WAIT_L(8); PG8_BAR; PG8_WAIT_L(0); PG8_MMA(0, 0, At, B0); PG8_BAR; PG8_SCHED;
            PG8_LDB(B1, 1, 1); PG8_STAGE(PG8_SB(1, 0), b3, voffB);
            PG8_BAR; PG8_WAIT_L(0); PG8_MMA(0, 1, At, B1); PG8_BAR;
            PG8_LDA(At, 1, 1); PG8_STAGE(PG8_SA(1, 0), a3, voffA);
            PG8_BAR; PG8_WAIT_L(0); PG8_MMA(1, 0, At, B0); PG8_BAR; PG8_SCHED;
            PG8_STAGE(PG8_SB(1, 1), b3 + hstep, voffB);
            PG8_WAIT_V(6); PG8_BAR; PG8_MMA(1, 1, At, B1); PG8_BAR;
            }
        }
        if constexpr (ALIGN_EPI) { if (wr == 0) PG8_BAR; }
        E(acc, cur, wr, wc, rsl, 0); S.done(cur);
        if (!has_next) break;
#pragma unroll
        for (int a = 0; a < 2; ++a)
#pragma unroll
            for (int b = 0; b < 2; ++b)
#pragma unroll
                for (int m = 0; m < 4; ++m)
#pragma unroll
                    for (int n = 0; n < 2; ++n) acc[a][b][m][n] = (f32x4){0.f, 0.f, 0.f, 0.f};
        cur = nxt; cA = nA; cB = nB; ++ui;
        if constexpr (ALIGN_EPI) { if (wr == 1) PG8_BAR; }
    }
    PG8_WAIT_V(0);
    if constexpr (!ALIGN_EPI) { if (wr == 0) PG8_BAR; }
    PG8_BAR;
#undef PG8_SA
#undef PG8_SB
#undef PG8_STAGE
#undef PG8_LDA
#undef PG8_LDB
#undef PG8_MMA
#undef PG8_WAIT_V
#undef PG8_WAIT_L
#undef PG8_BAR
#undef PG8_SCHED
}
}

#define XB_TMO      128
#define XB_XCNT(j)  (256  + 64 * (j))
#define XB_XSUB(j)  (1280 + 64 * (j))
#define XB_XGEN(j)  (2304 + 64 * (j))
#define XB_TOP      3328
#define XB_TOPGEN   3392
#define XCD_BAR_WORDS 3456
#define XB_SPIN_CAP (1u << 18)

__device__ __forceinline__ unsigned xb_ld(unsigned* p)              { return __hip_atomic_load(p, __ATOMIC_RELAXED, __HIP_MEMORY_SCOPE_AGENT); }
__device__ __forceinline__ unsigned xb_add(unsigned* p, unsigned v) { return __hip_atomic_fetch_add(p, v, __ATOMIC_RELAXED, __HIP_MEMORY_SCOPE_AGENT); }
__device__ __forceinline__ unsigned xb_xcc_id() { return (unsigned)__builtin_amdgcn_s_getreg((3 << 11) | 20) & 0xFu; }
#define XB_SPIN(cond, bar) do { unsigned _sp = 0; while (cond) { __builtin_amdgcn_s_sleep(1); \
    if ((++_sp & 255u) == 0u) { if (xb_ld(&(bar)[XB_TMO])) break; if (_sp > XB_SPIN_CAP) { atomicAdd(&(bar)[XB_TMO], 1u); break; } } } } while (0)

struct XcdBarrier {
    unsigned* bar; unsigned x;
    volatile LAS unsigned* st;
};
__device__ __forceinline__ XcdBarrier xcd_barrier_post(unsigned* bar, volatile LAS unsigned* st) {
    XcdBarrier b; b.bar = bar; b.x = xb_xcc_id(); b.st = st;
    if (threadIdx.x == 0) (void)xb_add(&bar[XB_XCNT(b.x)], 1u);
    return b;
}
__device__ __forceinline__ void xcd_barrier_complete(unsigned* bar, unsigned x, unsigned& nloc, unsigned& nx) {
    const unsigned G = gridDim.x * gridDim.y * gridDim.z;
    unsigned sum, cnt, mine, sp = 0u;
    for (;;) {
        sum = 0u; cnt = 0u; mine = 0u;
#pragma unroll
        for (unsigned j = 0; j < 16; ++j) { const unsigned c = xb_ld(&bar[XB_XCNT(j)]); sum += c; cnt += (c > 0u) ? 1u : 0u; mine = (j == x) ? c : mine; }
        if (sum == G) break;
        __builtin_amdgcn_s_sleep(1);
        if ((++sp & 255u) == 0u) { if (xb_ld(&bar[XB_TMO])) break; if (sp > XB_SPIN_CAP) { atomicAdd(&bar[XB_TMO], 1u); break; } }
    }
    nloc = mine > 0u ? mine : 1u; nx = cnt > 0u ? cnt : 1u;
}
__device__ __forceinline__ void xcd_barrier(const XcdBarrier& b, bool leader) {
    asm volatile("s_waitcnt vmcnt(0)" ::: "memory");
    __syncthreads();
    if (leader) {
        unsigned* bar = b.bar;
        __builtin_amdgcn_s_waitcnt(0);
        unsigned nloc = b.st[0], nx = b.st[1];
        const unsigned old = xb_add(&bar[XB_XSUB(b.x)], 1u);
        const unsigned gen = old / nloc;
        if (old + 1u == (gen + 1u) * nloc) {
            __builtin_amdgcn_fence(__ATOMIC_RELEASE, "agent");
            asm volatile("s_waitcnt vmcnt(0)" ::: "memory");
            const unsigned og = xb_add(&bar[XB_TOP], 1u);
            const unsigned tg = og / nx;
            if (og + 1u == (tg + 1u) * nx) xb_add(&bar[XB_TOPGEN], 1u);
            else XB_SPIN(xb_ld(&bar[XB_TOPGEN]) == tg, bar);
            __builtin_amdgcn_fence(__ATOMIC_ACQUIRE, "agent");
            xb_add(&bar[XB_XGEN(b.x)], 1u);
            asm volatile("s_waitcnt vmcnt(0)" ::: "memory");
        } else {
            XB_SPIN(xb_ld(&bar[XB_XGEN(b.x)]) == gen, bar);
            __builtin_amdgcn_fence(__ATOMIC_ACQUIRE, "agent");
            asm volatile("s_waitcnt vmcnt(0)" ::: "memory");
        }
    }
    __syncthreads();
}

struct Args {
    const float* in[19];
    float* out;
    unsigned char* ws;
    int ph_lo, ph_hi;
};
typedef const Args __attribute__((address_space(4))) KArgs;
struct Frame {
    LAS unsigned char* lds;
    unsigned char* ws; float* out;
    int tid, lane, wave, G, gw, NGW;
};

constexpr int CW_DQ = 8192;
constexpr int DQ_LDS = LDSCTL_OFF;
#define DYN_LOOP_BEGIN(u, NU, qid) { unsigned* dq_ctr_ = (unsigned*)(F.ws + WS_CTL) + CW_DQ + 64 * (qid); volatile LAS int* dq_l_ = (volatile LAS int*)(F.lds + DQ_LDS); \
    __syncthreads(); if (F.tid == 0) *dq_l_ = (int)__hip_atomic_fetch_add(dq_ctr_, 1u, __ATOMIC_RELAXED, __HIP_MEMORY_SCOPE_AGENT); __syncthreads(); int u = *dq_l_; \
    while (u < (NU)) { int dq_n_ = 0; if (F.tid == 0) dq_n_ = (int)__hip_atomic_fetch_add(dq_ctr_, 1u, __ATOMIC_RELAXED, __HIP_MEMORY_SCOPE_AGENT);
#define DYN_LOOP_END(u) __syncthreads(); if (F.tid == 0) *dq_l_ = dq_n_; __syncthreads(); u = *dq_l_; } }

__device__ __forceinline__ void transpose_item(const float* W, int K, int Nsrc, const float* kscale, bf16* WT, int k0, int ns0, int nd0, LAS float* scr, int lane) {
    if (ns0 >= 0) {
        float v[32];
#pragma unroll
        for (int i = 0; i < 32; ++i) { const int kk = 2 * i + (lane >> 5); v[i] = W[(size_t)(k0 + kk) * Nsrc + ns0 + (lane & 31)]; }
        if (kscale) {
#pragma unroll
            for (int i = 0; i < 32; ++i) { const int kk = 2 * i + (lane >> 5); v[i] *= kscale[k0 + kk]; } }
#pragma unroll
        for (int i = 0; i < 32; ++i) { const int kk = 2 * i + (lane >> 5); scr[kk * 33 + (lane & 31)] = v[i]; }
    } else {
#pragma unroll 8
        for (int i = 0; i < 32; ++i) { const int kk = 2 * i + (lane >> 5); scr[kk * 33 + (lane & 31)] = 0.f; }
    }
    LDS_WAIT(); asm volatile("" ::: "memory");
    const int c = lane & 7;
#pragma unroll
    for (int j = 0; j < 4; ++j) { const int n = (lane >> 3) + 8 * j; const LAS float* s = scr + (8 * c) * 33 + n;
        v4u o; o.x = pk2(s[0 * 33], s[1 * 33]); o.y = pk2(s[2 * 33], s[3 * 33]); o.z = pk2(s[4 * 33], s[5 * 33]); o.w = pk2(s[6 * 33], s[7 * 33]);
        *(v4u*)(WT + (size_t)(nd0 + n) * K + k0 + 8 * c) = o; }
    LDS_WAIT(); asm volatile("" ::: "memory");
}

constexpr int I_IN = (D / 64) * (IN_N / 32), I_OUT = (D / 64) * (D / 32), I_UP = (D / 64) * (FF / 32), I_DN = (FF / 64) * (D / 32);
__device__ __forceinline__ void convert_item(const Frame& F, KArgs& a, int m, int layer, int r, LAS float* scr, int lane) {
    unsigned char* ws = F.ws;
    if (m == 0) { const int nblk = IN_N / 32, kb = r / nblk, nb = r % nblk, nd0 = nb * 32;
        const int ns0 = nd0 < 2560 ? nd0 : (nd0 < 10240 ? nd0 + 32 : (nd0 < 10272 ? 2560 : -1));
        transpose_item(a.in[4] + (size_t)layer * D * IN_SRC, D, IN_SRC, a.in[3] + layer * D, (bf16*)(ws + WS_WIN + layer * SZ_WIN), kb * 64, ns0, nd0, scr, lane); }
    else if (m == 1) { const int nblk = D / 32, kb = r / nblk, nb = r % nblk;
        transpose_item(a.in[14] + (size_t)layer * D * D, D, D, nullptr, (bf16*)(ws + WS_WOUT + layer * SZ_WOUT), kb * 64, nb * 32, nb * 32, scr, lane); }
    else if (m == 2) { const int nblk = FF / 32, kb = r / nblk, nb = r % nblk;
        transpose_item(a.in[16] + (size_t)layer * D * FF, D, FF, a.in[15] + layer * D, (bf16*)(ws + WS_WUP + layer * SZ_WUP), kb * 64, nb * 32, nb * 32, scr, lane); }
    else { const int nblk = D / 32, kb = r / nblk, nb = r % nblk;
        transpose_item(a.in[17] + (size_t)layer * FF * D, FF, D, nullptr, (bf16*)(ws + WS_WDN + layer * SZ_WDN), kb * 64, nb * 32, nb * 32, scr, lane); }
}
__device__ __forceinline__ int bg_entries(int list, int layer) { return list == 0 ? I_UP / 64 : (list == 1 ? I_OUT / 64 : (layer == 0 ? (I_DN + I_IN) / 64 : I_DN / 64)); }
__device__ __forceinline__ void bg_entry(const Frame& F, KArgs& a, int list, int layer, int e) {
    __syncthreads();
    LAS float* scr = (LAS float*)(F.lds + RING_OFF + F.wave * 16384);
    const int ln = opaque_lane();
#pragma unroll 1
    for (int j = 0; j < 8; ++j) { const int r = e * 64 + F.wave * 8 + j;
        if (list == 0) convert_item(F, a, 2, layer, r, scr, ln);
        else if (list == 1) convert_item(F, a, 1, layer, r, scr, ln);
        else { if (r < I_DN) convert_item(F, a, 3, layer, r, scr, ln); else convert_item(F, a, 0, layer + 1, r - I_DN, scr, ln); } }
}
__device__ __forceinline__ int bg_split(int q, int NU, int NB, int& unit) { const int T = NU + NB, b0 = (q * NB) / T, b1 = ((q + 1) * NB) / T; unit = q - b0; return b1 > b0 ? b0 : -1; }

__device__ __forceinline__ void p_prologue(const Frame& F, KArgs& a) {
    LAS float* scr = (LAS float*)(F.lds + RING_OFF + F.wave * 16384);
    unsigned char* ws = F.ws;
    for (int it = F.gw; it < I_IN; it += F.NGW) convert_item(F, a, 0, 0, it, scr, F.lane);
    float* hm = (float*)(ws + WS_HM);
    bf16* XN = (bf16*)(ws + WS_HB);
    float* rs0 = (float*)(ws + WS_RSTD);
    for (int row = F.gw; row < MP; row += F.NGW) {
        v2u* o = (v2u*)(XN + (size_t)row * D);
        if (row >= NTOK) {
            float* dst = hm + (size_t)(row - NREAL) * D;
            v2u* xm = (v2u*)((bf16*)(ws + WS_XN) + (size_t)row * D);
#pragma unroll
            for (int j = 0; j < 16; ++j) { ((f32x4*)dst)[F.lane + 64 * j] = (f32x4){0.f, 0.f, 0.f, 0.f}; o[F.lane + 64 * j] = (v2u){0u, 0u}; xm[F.lane + 64 * j] = (v2u){0u, 0u}; }
            if (F.lane == 0) rs0[row] = 0.f;
            continue; }
        const f32x4* src; float* dst;
        if (row < NREAL) { src = (const f32x4*)((row < 8192 ? a.in[0] + (size_t)row * D : a.in[1] + (size_t)(row - 8192) * D)); dst = nullptr; }
        else { src = (const f32x4*)(a.in[2] + (size_t)((row - NREAL) & 15) * D); dst = hm + (size_t)(row - NREAL) * D; }
        float sq = 0.f;
#pragma unroll
        for (int j = 0; j < 16; ++j) { const f32x4 v = src[F.lane + 64 * j];
            if (dst) ((f32x4*)dst)[F.lane + 64 * j] = v;
            o[F.lane + 64 * j] = (v2u){pk2(v.x, v.y), pk2(v.z, v.w)}; sq += (v.x * v.x + v.y * v.y) + (v.z * v.z + v.w * v.w); }
        sq = wave_sum(sq);
        if (F.lane == 0) rs0[row] = rsqrtf(sq * (1.f / D) + EPS);
    }
}

__device__ __forceinline__ void p_norm_meta(const Frame& F, int k) {
    float* hm = (float*)(F.ws + WS_HM);
    const float* slab = (const float*)(F.ws + WS_SLAB);
    bf16* XN = (bf16*)(F.ws + WS_HB);
    float* rs = (float*)(F.ws + WS_RSTD) + (size_t)k * MP;
    const float* ssp = (const float*)(F.ws + WS_SSP);
    for (int row = F.gw * 4; row < NREAL; row += F.NGW * 4) {
        float t[4];
#pragma unroll
        for (int j = 0; j < 4; ++j) t[j] = ssp[(size_t)(row + j) * 64 + F.lane];
#pragma unroll
        for (int j = 0; j < 4; ++j) t[j] = wave_sum(t[j]);
        if (F.lane == 0) {
#pragma unroll
            for (int j = 0; j < 4; ++j) rs[row + j] = rsqrtf(t[j] * (1.f / D) + EPS); } }
    for (int mr = F.gw; mr < 256; mr += F.NGW) {
        const int row = NREAL + mr;
        v2u* o = (v2u*)(XN + (size_t)row * D);
        if (F.lane == 0) rs[row] = 1.f;
        if (mr >= NSEQ * NMETA) {
#pragma unroll
            for (int j = 0; j < 16; ++j) o[F.lane + 64 * j] = (v2u){0u, 0u};
            continue; }
        f32x4* src = (f32x4*)(hm + (size_t)mr * D);
        f32x4 v[16]; float sq = 0.f;
#pragma unroll
        for (int j = 0; j < 16; ++j) v[j] = src[F.lane + 64 * j];
#pragma unroll 1
        for (int ks = 0; ks < 16; ++ks) { const f32x4* sp = (const f32x4*)(slab + ((size_t)ks * 256 + mr) * D);
#pragma unroll
            for (int j = 0; j < 16; ++j) v[j] = v[j] + sp[F.lane + 64 * j]; }
#pragma unroll
        for (int j = 0; j < 16; ++j) { src[F.lane + 64 * j] = v[j]; sq += (v[j].x * v[j].x + v[j].y * v[j].y) + (v[j].z * v[j].z + v[j].w * v[j].w); }
        const float rstd = rsqrtf(wave_sum(sq) * (1.f / D) + EPS);
#pragma unroll
        for (int j = 0; j < 16; ++j) o[F.lane + 64 * j] = (v2u){pk2(v[j].x * rstd, v[j].y * rstd), pk2(v[j].z * rstd, v[j].w * rstd)};
    }
}
__device__ __forceinline__ void p_final_norm(const Frame& F, KArgs& a) {
    const f32x4* w = (const f32x4*)a.in[18];
    const float* ssp = (const float*)(F.ws + WS_SSP);
    const bf16* HB = (const bf16*)(F.ws + WS_HB);
    for (int row0 = F.gw * 2; row0 < NREAL; row0 += F.NGW * 2) {
        v2u hv[2][16]; float sp[2];
#pragma unroll
        for (int q = 0; q < 2; ++q) { const v2u* hsrc = (const v2u*)(HB + (size_t)(row0 + q) * D); sp[q] = ssp[(size_t)(row0 + q) * 64 + F.lane];
#pragma unroll
            for (int j = 0; j < 16; ++j) hv[q][j] = hsrc[F.lane + 64 * j]; }
#pragma unroll
        for (int q = 0; q < 2; ++q) { f32x4* p = (f32x4*)(F.out + (size_t)(row0 + q) * D);
            const float rstd = rsqrtf(wave_sum(sp[q]) * (1.f / D) + EPS);
#pragma unroll
            for (int j = 0; j < 16; ++j) { const f32x4 v = (f32x4){bflo(hv[q][j].x), bfhi(hv[q][j].x), bflo(hv[q][j].y), bfhi(hv[q][j].y)}; p[F.lane + 64 * j] = v * rstd * w[F.lane + 64 * j]; } }
    }
}

__device__ __forceinline__ void p_ssd_prep(const Frame& F, KArgs& a, int layer) {
    const bf16* P = (const bf16*)(F.ws + WS_P);
    const float* DT = (const float*)(F.ws + WS_DT);
    float* DTL = (float*)(F.ws + WS_DTL);
    bf16* XBC = (bf16*)(F.ws + WS_XBC);
    const float* cw = a.in[5] + (size_t)layer * 5 * 1536;
    const float* cb = a.in[6] + (size_t)layer * 1536;
    const int NW3 = F.NGW / 3;
    if (F.gw >= 3 * NW3) return;
    const int cc = F.gw % 3, k0 = F.gw / 3;
    const int c0 = cc * 512 + F.lane * 8;
    float wgt[5][8], bias[8];
#pragma unroll
    for (int i = 0; i < 8; ++i) bias[i] = cb[c0 + i];
#pragma unroll
    for (int j = 0; j < 5; ++j)
#pragma unroll
        for (int i = 0; i < 8; ++i) wgt[j][i] = cw[j * 1536 + c0 + i];
    const int dl = F.lane & 31, dp = F.lane >> 5;
    const float dtb = a.in[7][layer * 32 + dl], aexp = __expf(a.in[8][layer * 32 + dl]);
    constexpr int RL = 16, NROW = RL + 4, RUNS_P = 257, RUNS_S = 129;
    constexpr int NRUN = 2 * RUNS_P + 8 * RUNS_S;
#pragma unroll 1
    for (int run = k0; run < NRUN; run += NW3) {
        int s, l0;
        if (run < 2 * RUNS_P) { s = run / RUNS_P; l0 = (run - s * RUNS_P) * RL; } else { const int q = run - 2 * RUNS_P; s = 2 + q / RUNS_S; l0 = (q - (s - 2) * RUNS_S) * RL; }
        const int L = seq_T(s) + NMETA;
        v4u rw[NROW];
#pragma unroll
        for (int j = 0; j < NROW; ++j) { const int lj = l0 - 2 + j; const bool ok = lj >= 0 && lj < L;
            rw[j] = ok ? *(const v4u*)(P + (size_t)row_of(s, lj) * P_LD + PC_XBC + c0) : (v4u){0u, 0u, 0u, 0u}; }
        float dtv[RL / 2];
        if (cc == 0) {
#pragma unroll
            for (int t2 = 0; t2 < RL / 2; ++t2) { const int l = l0 + 2 * t2 + dp; dtv[t2] = l < L ? DT[(size_t)row_of(s, l) * 32 + dl] : 0.f; }
        }
        float acc[RL][8];
#pragma unroll
        for (int t = 0; t < RL; ++t)
#pragma unroll
            for (int i = 0; i < 8; ++i) acc[t][i] = bias[i];
#pragma unroll
        for (int j = 0; j < NROW; ++j) {
            float x[8]; unpack8(rw[j], x);
#pragma unroll
            for (int jj = 0; jj < 5; ++jj) { const int t = j - jj; if (t < 0 || t >= RL) continue;
#pragma unroll
                for (int i = 0; i < 8; ++i) acc[t][i] += wgt[jj][i] * x[i]; }
            const int td = j - 4;
            if (td >= 0) { const int l = l0 + td;
                if (l < L) { v4u o; o.x = pk2(siluf(acc[td][0]), siluf(acc[td][1])); o.y = pk2(siluf(acc[td][2]), siluf(acc[td][3])); o.z = pk2(siluf(acc[td][4]), siluf(acc[td][5])); o.w = pk2(siluf(acc[td][6]), siluf(acc[td][7]));
                    *(v4u*)(XBC + (size_t)row_of(s, l) * 1536 + c0) = o; } }
        }
        if (cc == 0) {
#pragma unroll
            for (int t2 = 0; t2 < RL / 2; ++t2) { const int l = l0 + 2 * t2 + dp;
                if (l < L) { const int row = row_of(s, l); const float x = dtv[t2] + dtb; const float sp = x > 20.f ? x : log1pf(__expf(x));
                    DTL[(size_t)row * 64 + dl] = sp; DTL[(size_t)row * 64 + 32 + dl] = -sp * aexp; } }
        }
    }
}

typedef short s16x4 __attribute__((ext_vector_type(4)));
typedef short v4i16_t __attribute__((ext_vector_type(4)));
constexpr int NCHUNK = 202;
__device__ __forceinline__ void chunk_decode(int cid, int& s, int& c) { if (cid < 66) { s = cid / 33; c = cid - s * 33; } else { const int q = cid - 66; const int s2 = q / 17; s = 2 + s2; c = q - s2 * 17; } }
__device__ __forceinline__ int chunk_row(int s, int c, int t) { return c == 0 ? (t < 112 ? -1 : META0 + s * NMETA + t - 112) : seq_start(s) + (c - 1) * 128 + t; }
__device__ __forceinline__ s16x4 lds_tr(const LAS unsigned char* p) { return __builtin_bit_cast(s16x4, __builtin_amdgcn_ds_read_tr16_b64_v4i16((LAS v4i16_t*)p)); }
__device__ __forceinline__ bf16x8 cat4(s16x4 a, s16x4 b) { return (bf16x8){a[0], a[1], a[2], a[3], b[0], b[1], b[2], b[3]}; }
__device__ __forceinline__ f32x4 mfma16(bf16x8 a, bf16x8 b, f32x4 c) { return __builtin_amdgcn_mfma_f32_16x16x32_bf16(a, b, c, 0, 0, 0); }
__device__ __forceinline__ bf16x8 pack8(const float (&f)[8]) { v4u w; w.x = pk2(f[0], f[1]); w.y = pk2(f[2], f[3]); w.z = pk2(f[4], f[5]); w.w = pk2(f[6], f[7]); return __builtin_bit_cast(bf16x8, w); }

constexpr int XPITCH = 144;
constexpr int SA_BIMG = 0, SA_XP = 73728, SA_DEC = 110592;
constexpr int SC_CIMG = 0, SC_BIMG = 36864, SC_XP = 73728, SC_DEC = 110592, SC_XCH = 126976;
static_assert(SC_XCH + 4096 <= RING_BYTES, "scan LDS map");

constexpr int NHS = 24;

__device__ __forceinline__ float wave_incl_scan(float v, int lane) {
#pragma unroll
    for (int o = 1; o < 64; o <<= 1) { const float u = __shfl_up(v, o); if (lane >= o) v += u; }
    return v;
}
constexpr float LOG2E_G = 1.4426950408889634f;
__device__ __forceinline__ void decay_setup(LAS float* dec, float laf0, float laf1, float lab0, float lab1, float dtf0, float dtf1, float dtb0, float dtb1, int lane, float& cfe, float& cbe) {
    laf0 *= LOG2E_G; laf1 *= LOG2E_G; lab0 *= LOG2E_G; lab1 *= LOG2E_G;
    float f0 = wave_incl_scan(laf0, lane), f1 = wave_incl_scan(laf1, lane);
    const float ft = __shfl(f0, 63); f1 += ft;
    float b0 = wave_incl_scan(lab0, lane), b1 = wave_incl_scan(lab1, lane);
    const float bt = __shfl(b0, 63); b1 += bt;
    cfe = __shfl(f1, 63); cbe = __shfl(b1, 63);
    dec[lane] = f0; dec[64 + lane] = f1;
    dec[128 + lane] = b0 - lab0; dec[192 + lane] = b1 - lab1;
    dec[256 + lane] = __log2f(dtf0) - f0; dec[320 + lane] = __log2f(dtf1) - f1;
    dec[384 + lane] = (b0 - lab0) + __log2f(dtb0); dec[448 + lane] = (b1 - lab1) + __log2f(dtb1);
    LDS_WAIT();
}
struct DecRaw { float laf0, laf1, lab0, lab1, dtf0, dtf1, dtb0, dtb1; };
template <bool SSD>
__device__ __forceinline__ DecRaw decay_raw(const Frame& F, KArgs& a, int layer, int s, int c, int h, int lane) {
    const int r0 = chunk_row(s, c, lane), r1 = chunk_row(s, c, 64 + lane);
    DecRaw d{0.f, 0.f, 0.f, 0.f, 0.f, 0.f, 0.f, 0.f};
    if (SSD) {
        const float* DTL = (const float*)(F.ws + WS_DTL);
        if (r0 >= 0) { const float* p = DTL + (size_t)r0 * 64; d.dtf0 = p[h]; d.dtb0 = p[16 + h]; d.laf0 = p[32 + h]; d.lab0 = p[48 + h]; }
        if (r1 >= 0) { const float* p = DTL + (size_t)r1 * 64; d.dtf1 = p[h]; d.dtb1 = p[16 + h]; d.laf1 = p[32 + h]; d.lab1 = p[48 + h]; }
    } else {
        const float x0 = a.in[13][layer * 16 + h], x1 = a.in[13][layer * 16 + 8 + h];
        const float lgf = fminf(x0, 0.f) - log1pf(__expf(-fabsf(x0))), lgb = fminf(x1, 0.f) - log1pf(__expf(-fabsf(x1)));
        if (r0 >= 0) { d.laf0 = lgf; d.lab0 = lgb; d.dtf0 = 0.125f; d.dtb0 = 0.125f; }
        if (r1 >= 0) { d.laf1 = lgf; d.lab1 = lgb; d.dtf1 = 0.125f; d.dtb1 = 0.125f; }
    }
    return d;
}
template <bool SSD>
__device__ __forceinline__ void decay_load(const Frame& F, KArgs& a, int layer, int s, int c, int h, int lane, LAS float* dec, float& cfe, float& cbe) {
    const DecRaw d = decay_raw<SSD>(F, a, layer, s, c, h, lane);
    decay_setup(dec, d.laf0, d.laf1, d.lab0, d.lab1, d.dtf0, d.dtf1, d.dtb0, d.dtb1, lane, cfe, cbe);
}
template <int NROWS, int PPR>
__device__ __forceinline__ void stage_rows_ld(v4u (&v)[NROWS * PPR / NTHREADS], const bf16* src, int ld, int col0, int s, int c, int t0, int tid) {
    static_assert((NROWS * PPR) % NTHREADS == 0, "stage_rows");
#pragma unroll
    for (int q = 0; q < NROWS * PPR / NTHREADS; ++q) { const int idx = tid + q * NTHREADS, r = idx / PPR, pc = idx % PPR;
        if (c != 0) v[q] = *(const v4u*)(src + (size_t)(seq_start(s) + (c - 1) * 128 + t0 + r) * ld + col0 + pc * 8);
        else { const int row = chunk_row(s, c, t0 + r); v[q] = row >= 0 ? *(const v4u*)(src + (size_t)row * ld + col0 + pc * 8) : (v4u){0u, 0u, 0u, 0u}; } }
}
template <int NROWS, int PPR>
__device__ __forceinline__ void stage_rows_st(const v4u (&v)[NROWS * PPR / NTHREADS], LAS unsigned char* dst, int pitchB, int tid) {
#pragma unroll
    for (int q = 0; q < NROWS * PPR / NTHREADS; ++q) { const int idx = tid + q * NTHREADS, r = idx / PPR, pc = idx % PPR; *(LAS v4u*)(dst + r * pitchB + pc * 16) = v[q]; }
}
template <int NROWS, int PPR>
__device__ __forceinline__ void stage_rows(LAS unsigned char* dst, int pitchB, const bf16* src, int ld, int col0, int s, int c, int t0, int tid) {
    v4u v[NROWS * PPR / NTHREADS]; stage_rows_ld<NROWS, PPR>(v, src, ld, col0, s, c, t0, tid); stage_rows_st<NROWS, PPR>(v, dst, pitchB, tid);
}
template <bool FAST = false>
__device__ __forceinline__ void xblock_load(v4u (&xr)[4], const bf16* src, int ld, int col0, int s, int c, int sb, int lane) {
    if (FAST && c != 0) {
        const bf16* base = src + (size_t)(seq_start(s) + (c - 1) * 128 + sb * 32) * ld + col0;
#pragma unroll
        for (int q = 0; q < 4; ++q) { const unsigned off = (unsigned)(((lane >> 3) + 8 * q) * ld + (lane & 7) * 8) * 2u; xr[q] = *(const v4u*)((const unsigned char*)base + off); }
        return;
    }
#pragma unroll
    for (int q = 0; q < 4; ++q) { const int idx = lane + 64 * q, r = idx >> 3, pc = idx & 7; const int row = chunk_row(s, c, sb * 32 + r);
        xr[q] = row >= 0 ? *(const v4u*)(src + (size_t)row * ld + col0 + pc * 8) : (v4u){0u, 0u, 0u, 0u}; }
}
__device__ __forceinline__ void xblock_store(const v4u (&xr)[4], LAS unsigned char* xp, int lane) {
#pragma unroll
    for (int q = 0; q < 4; ++q) { const int idx = lane + 64 * q, r = idx >> 3, pc = idx & 7; *(LAS v4u*)(xp + r * XPITCH + pc * 16) = xr[q]; }
}

template <int NK>
__device__ __forceinline__ void scanA_job(const LAS unsigned char* bimg, LAS unsigned char* xp, const LAS float* dec, float cfe,
                                          const bf16* xsrc, int xld, int xcol0, int s, int c, bf16* locf, bf16* locb, int lane, const v4u (&xr0)[4]) {
    constexpr int NKP2 = (NK + 8) * 2, NPASS = NK / 64;
    const int g = lane >> 4, i = lane & 15;
#pragma unroll 1
    for (int np = 0; np < NPASS; ++np) {
        f32x4 Lf[4][4], Lb[4][4];
#pragma unroll
        for (int pt = 0; pt < 4; ++pt)
#pragma unroll
            for (int nt = 0; nt < 4; ++nt) { Lf[pt][nt] = (f32x4){0.f, 0.f, 0.f, 0.f}; Lb[pt][nt] = (f32x4){0.f, 0.f, 0.f, 0.f}; }
        v4u xr[4];
        if (np == 0) {
#pragma unroll
            for (int q = 0; q < 4; ++q) xr[q] = xr0[q]; } else xblock_load(xr, xsrc, xld, xcol0, s, c, 0, lane);
#pragma unroll 1
        for (int sb = 0; sb < 4; ++sb) {
            xblock_store(xr, xp, lane);
            if (sb < 3) xblock_load(xr, xsrc, xld, xcol0, s, c, sb + 1, lane);
            float wf[8], wb[8];
            { const LAS float* d = dec + sb * 32 + 8 * g;
              const f32x4 a0 = *(const LAS f32x4*)(d + 256), a1 = *(const LAS f32x4*)(d + 260), b0 = *(const LAS f32x4*)(d + 384), b1 = *(const LAS f32x4*)(d + 388);
#pragma unroll
              for (int j = 0; j < 4; ++j) { wf[j] = __builtin_amdgcn_exp2f(cfe + a0[j]); wf[4 + j] = __builtin_amdgcn_exp2f(cfe + a1[j]); wb[j] = __builtin_amdgcn_exp2f(b0[j]); wb[4 + j] = __builtin_amdgcn_exp2f(b1[j]); } }
            LDS_WAIT();
            bf16x8 xaf[4], xab[4];
#pragma unroll
            for (int pt = 0; pt < 4; ++pt) {
                const LAS unsigned char* ap = xp + (8 * g + (i >> 2)) * XPITCH + (16 * pt + 4 * (i & 3)) * 2;
                const bf16x8 raw = cat4(lds_tr(ap), lds_tr(ap + 4 * XPITCH));
                float x[8]; unpack8(__builtin_bit_cast(v4u, raw), x);
                float xf[8], xb[8];
#pragma unroll
                for (int j = 0; j < 8; ++j) { xf[j] = x[j] * wf[j]; xb[j] = x[j] * wb[j]; }
                xaf[pt] = pack8(xf); xab[pt] = pack8(xb);
            }
#pragma unroll
            for (int nt = 0; nt < 4; ++nt) {
                const LAS unsigned char* bp = bimg + (sb * 32 + 8 * g + (i >> 2)) * NKP2 + (np * 64 + 16 * nt + 4 * (i & 3)) * 2;
                const bf16x8 bb = cat4(lds_tr(bp), lds_tr(bp + 4 * NKP2));
#pragma unroll
                for (int pt = 0; pt < 4; ++pt) { Lf[pt][nt] = mfma16(xaf[pt], bb, Lf[pt][nt]); Lb[pt][nt] = mfma16(xab[pt], bb, Lb[pt][nt]); }
            }
        }
        { int lz = lane; asm volatile("" : "+v"(lz));
          const int ob = (4 * (lz >> 4)) * NK + np * 64 + (lz & 15);
#pragma unroll
          for (int pt = 0; pt < 4; ++pt)
#pragma unroll
            for (int nt = 0; nt < 4; ++nt)
#pragma unroll
                for (int r = 0; r < 4; ++r) { const int o = ob + (16 * pt + r) * NK + 16 * nt; locf[o] = (bf16)f2bf(Lf[pt][nt][r]); locb[o] = (bf16)f2bf(Lb[pt][nt][r]); } }
    }
}

__device__ __forceinline__ void p_scanA(const Frame& F, KArgs& a, int layer) {
    const bf16* P = (const bf16*)(F.ws + WS_P);
    const bf16* XBC = (const bf16*)(F.ws + WS_XBC);
    bf16* LOC = (bf16*)(F.ws + WS_LOC);
    float* CDEC = (float*)(F.ws + WS_CDEC);
    LAS unsigned char* xp = F.lds + SA_XP + F.wave * 4608;
    LAS float* dec = (LAS float*)(F.lds + SA_DEC + F.wave * 2048);
    const int NBG = bg_entries(1, layer);
    DYN_LOOP_BEGIN(q, 808 + NBG, layer * 4 + 1)
        int u; const int be = bg_split(q, 808, NBG, u);
        if (be >= 0) { bg_entry(F, a, 1, layer, be); } else {
        const bool ssd = u < 404; const int uu = ssd ? u : u - 404; const int cid = uu >> 1, sub = uu & 1;
        int s, c; chunk_decode(cid, s, c);
        __syncthreads();
        float cfe, cbe;
        int tz = F.tid; asm volatile("" : "+v"(tz));
        if (ssd) {
            const int h = sub * 8 + F.wave;
            v4u sb_[4]; stage_rows_ld<128, 16>(sb_, XBC, 1536, 1024 + sub * 128, s, c, 0, tz);
            const DecRaw dr = decay_raw<true>(F, a, layer, s, c, h, tz & 63);
            v4u xr0[4]; xblock_load(xr0, XBC, 1536, h * 64, s, c, 0, tz & 63);
            stage_rows_st<128, 16>(sb_, F.lds + SA_BIMG, 272, tz);
            decay_setup(dec, dr.laf0, dr.laf1, dr.lab0, dr.lab1, dr.dtf0, dr.dtf1, dr.dtb0, dr.dtb1, tz & 63, cfe, cbe);
            __syncthreads();
            bf16* lf = LOC + ((size_t)(cid * NHS + h) * 2) * 8192;
            int lz = F.lane; asm volatile("" : "+v"(lz));
            scanA_job<128>(F.lds + SA_BIMG, xp, dec, cfe, XBC, 1536, h * 64, s, c, lf, lf + 8192, lz, xr0);
            if (F.lane == 0) { CDEC[(cid * NHS + h) * 2] = __builtin_amdgcn_exp2f(cfe); CDEC[(cid * NHS + h) * 2 + 1] = __builtin_amdgcn_exp2f(cbe); }
        } else {
            const int hd = F.wave >> 1, vh = F.wave & 1, h = sub * 4 + hd;
            v4u sk_[4][2];
#pragma unroll
            for (int k = 0; k < 4; ++k) stage_rows_ld<128, 8>(sk_[k], P, P_LD, PC_RET + 512 + (sub * 4 + k) * 64, s, c, 0, tz);
            const DecRaw dr = decay_raw<false>(F, a, layer, s, c, h, tz & 63);
            v4u xr0[4]; xblock_load(xr0, P, P_LD, PC_RET + 1024 + h * 128 + vh * 64, s, c, 0, tz & 63);
#pragma unroll
            for (int k = 0; k < 4; ++k) stage_rows_st<128, 8>(sk_[k], F.lds + SA_BIMG + k * 18432, 144, tz);
            decay_setup(dec, dr.laf0, dr.laf1, dr.lab0, dr.lab1, dr.dtf0, dr.dtf1, dr.dtb0, dr.dtb1, tz & 63, cfe, cbe);
            __syncthreads();
            bf16* lf = LOC + ((size_t)(cid * NHS + 16 + h) * 2) * 8192 + vh * 64 * 64;
            int lz = F.lane; asm volatile("" : "+v"(lz));
            scanA_job<64>(F.lds + SA_BIMG + hd * 18432, xp, dec, cfe, P, P_LD, PC_RET + 1024 + h * 128 + vh * 64, s, c, lf, lf + 8192, lz, xr0);
            if (F.lane == 0 && vh == 0) { CDEC[(cid * NHS + 16 + h) * 2] = __builtin_amdgcn_exp2f(cfe); CDEC[(cid * NHS + 16 + h) * 2 + 1] = __builtin_amdgcn_exp2f(cbe); }
        }
        }
    DYN_LOOP_END(q)
    __syncthreads();
}

__device__ __forceinline__ void p_scanB(const Frame& F, KArgs& a) {
    const bf16* LOC = (const bf16*)(F.ws + WS_LOC);
    const float* CDEC = (const float*)(F.ws + WS_CDEC);
    bf16* SIN = (bf16*)(F.ws + WS_SIN);
    for (int it = blockIdx.x; it < 960; it += F.G) {
        const int sl = it & 1, dir = (it >> 1) & 1, hs = (it >> 2) % NHS, s = (it >> 2) / NHS;
        const int nch = s < 2 ? 33 : 17, cb = s < 2 ? s * 33 : 66 + (s - 2) * 17;
        const int e = sl * 4096 + F.tid * 8;
        v4u lv[33]; float dv[33];
#pragma unroll
        for (int k = 0; k < 33; ++k) { const int kk = k < nch ? k : nch - 1; const int c = dir == 0 ? kk : nch - 1 - kk; const size_t o = ((size_t)((cb + c) * NHS + hs) * 2 + dir) * 8192 + e;
            lv[k] = *(const v4u*)(LOC + o); dv[k] = CDEC[((cb + c) * NHS + hs) * 2 + dir]; }
        float run[8];
#pragma unroll
        for (int j = 0; j < 8; ++j) run[j] = 0.f;
#pragma unroll
        for (int k = 0; k < 33; ++k) {
            if (k < nch) { const int c = dir == 0 ? k : nch - 1 - k; const size_t o = ((size_t)((cb + c) * NHS + hs) * 2 + dir) * 8192 + e;
                v4u w; w.x = pk2(run[0], run[1]); w.y = pk2(run[2], run[3]); w.z = pk2(run[4], run[5]); w.w = pk2(run[6], run[7]);
                *(v4u*)(SIN + o) = w;
                float l[8]; unpack8(lv[k], l);
#pragma unroll
                for (int j = 0; j < 8; ++j) run[j] = run[j] * dv[k] + l[j]; }
        }
    }
}

template <int NK>
__device__ __forceinline__ void scanC_job(f32x4 (&y)[4][4], const LAS unsigned char* cimg, const LAS unsigned char* bimg, LAS unsigned char* xp, const LAS float* dec, float cbe,
                                          const bf16* xsrc, int xld, int xcol0, int s, int c, int lbase, float dskip, const bf16* sinf, const bf16* sinb, int lane, const v4u (&xr0)[4]) {
    constexpr int NKP2 = (NK + 8) * 2, KS = NK / 32;
    const int g = lane >> 4, i = lane & 15;
#pragma unroll
    for (int lt = 0; lt < 4; ++lt)
#pragma unroll
        for (int pt = 0; pt < 4; ++pt) y[lt][pt] = (f32x4){0.f, 0.f, 0.f, 0.f};
    v4u xr[4];
#pragma unroll
    for (int q = 0; q < 4; ++q) xr[q] = xr0[q];
#pragma unroll 1
    for (int sb = 0; sb < 4; ++sb) {
        xblock_store(xr, xp, lane);
        if (sb < 3) xblock_load<true>(xr, xsrc, xld, xcol0, s, c, sb + 1, lane);
        const LAS float* d = dec + sb * 32 + 4 * g;
        const f32x4 A0 = *(const LAS f32x4*)(d + 256), A1 = *(const LAS f32x4*)(d + 272), B0 = *(const LAS f32x4*)(d + 384), B1 = *(const LAS f32x4*)(d + 400);
        LDS_WAIT();
        bf16x8 xf[4];
#pragma unroll
        for (int pt = 0; pt < 4; ++pt) { const LAS unsigned char* ap = xp + (4 * g + (i >> 2)) * XPITCH + (16 * pt + 4 * (i & 3)) * 2; xf[pt] = cat4(lds_tr(ap), lds_tr(ap + 16 * XPITCH)); }
#pragma unroll
        for (int lt = 0; lt < 4; ++lt) {
            const int l = lbase + 16 * lt + i;
            const float cfl = dec[l], ebl = dec[128 + l];
            f32x4 t0 = (f32x4){0.f, 0.f, 0.f, 0.f}, t1 = (f32x4){0.f, 0.f, 0.f, 0.f};
#pragma unroll
            for (int kk = 0; kk < KS; ++kk) { const bf16x8 cf = *(const LAS bf16x8*)(cimg + (16 * lt + i) * NKP2 + (kk * 32 + 8 * g) * 2);
                const bf16x8 b0 = *(const LAS bf16x8*)(bimg + (sb * 32 + i) * NKP2 + (kk * 32 + 8 * g) * 2), b1 = *(const LAS bf16x8*)(bimg + (sb * 32 + 16 + i) * NKP2 + (kk * 32 + 8 * g) * 2);
                t0 = mfma16(b0, cf, t0); t1 = mfma16(b1, cf, t1); }
            float m[8];
            const int lt_lo = lbase + 16 * lt;
            if (sb * 32 + 31 < lt_lo) {
#pragma unroll
                for (int r = 0; r < 4; ++r) { m[r] = t0[r] * __builtin_amdgcn_exp2f(cfl + A0[r]); m[4 + r] = t1[r] * __builtin_amdgcn_exp2f(cfl + A1[r]); }
            } else if (sb * 32 > lt_lo + 15) {
#pragma unroll
                for (int r = 0; r < 4; ++r) { m[r] = t0[r] * __builtin_amdgcn_exp2f(B0[r] - ebl); m[4 + r] = t1[r] * __builtin_amdgcn_exp2f(B1[r] - ebl); }
            } else {
#pragma unroll
                for (int r = 0; r < 4; ++r) {
                    const int s0 = sb * 32 + 4 * g + r, s1 = s0 + 16;
                    m[r] = t0[r] * __builtin_amdgcn_exp2f(s0 <= l ? cfl + A0[r] : B0[r] - ebl) + (s0 == l ? dskip : 0.f);
                    m[4 + r] = t1[r] * __builtin_amdgcn_exp2f(s1 <= l ? cfl + A1[r] : B1[r] - ebl) + (s1 == l ? dskip : 0.f);
                }
            }
            const bf16x8 af = pack8(m);
#pragma unroll
            for (int pt = 0; pt < 4; ++pt) y[lt][pt] = mfma16(xf[pt], af, y[lt][pt]);
            __builtin_amdgcn_sched_barrier(0);
        }
    }
#pragma unroll 1
    for (int dir = 0; dir < 2; ++dir) {
        const bf16* S = dir == 0 ? sinf : sinb;
        bf16x8 sf[4][KS];
#pragma unroll
        for (int pt = 0; pt < 4; ++pt)
#pragma unroll
            for (int kk = 0; kk < KS; ++kk) sf[pt][kk] = *(const bf16x8*)(S + (size_t)(16 * pt + i) * NK + kk * 32 + 8 * g);
        float sc[4];
#pragma unroll
        for (int lt = 0; lt < 4; ++lt) { const int l = lbase + 16 * lt + i; sc[lt] = dir == 0 ? __builtin_amdgcn_exp2f(dec[l]) : __builtin_amdgcn_exp2f(cbe - dec[128 + l]); }
#pragma unroll
        for (int lt = 0; lt < 4; ++lt) {
            bf16x8 cf[KS];
#pragma unroll
            for (int kk = 0; kk < KS; ++kk) cf[kk] = *(const LAS bf16x8*)(cimg + (16 * lt + i) * NKP2 + (kk * 32 + 8 * g) * 2);
#pragma unroll
            for (int pt = 0; pt < 4; ++pt) {
                f32x4 t = (f32x4){0.f, 0.f, 0.f, 0.f};
#pragma unroll
                for (int kk = 0; kk < KS; ++kk) t = mfma16(sf[pt][kk], cf[kk], t);
                y[lt][pt] = y[lt][pt] + t * sc[lt];
            }
        }
    }
}

__device__ __forceinline__ void p_scanC(const Frame& F, KArgs& a, int layer) {
    const bf16* P = (const bf16*)(F.ws + WS_P);
    const bf16* XBC = (const bf16*)(F.ws + WS_XBC);
    const bf16* SIN = (const bf16*)(F.ws + WS_SIN);
    bf16* XN = (bf16*)(F.ws + WS_XN);
    LAS unsigned char* xp = F.lds + SC_XP + F.wave * 4608;
    LAS float* dec = (LAS float*)(F.lds + SC_DEC + F.wave * 2048);
    LAS float* xch = (LAS float*)(F.lds + SC_XCH);
    const int NBG = bg_entries(2, layer);
    DYN_LOOP_BEGIN(q, 1616 + NBG, layer * 4 + 2)
        int u; const int be = bg_split(q, 1616, NBG, u);
        if (be >= 0) { bg_entry(F, a, 2, layer, be); } else {
        const bool ssd = u < 808; const int uu = ssd ? u : u - 808; const int cid = uu >> 2, sub = uu & 3;
        int s, c; chunk_decode(cid, s, c);
        __syncthreads();
        float cfe, cbe; f32x4 y[4][4];
        int tz = F.tid; asm volatile("" : "+v"(tz));
        if (ssd) {
            const int grp = sub >> 1, lh = sub & 1, h = grp * 8 + F.wave;
            v4u sc_[2], sb_[4]; stage_rows_ld<64, 16>(sc_, XBC, 1536, 1280 + grp * 128, s, c, lh * 64, tz); stage_rows_ld<128, 16>(sb_, XBC, 1536, 1024 + grp * 128, s, c, 0, tz);
            const DecRaw dr = decay_raw<true>(F, a, layer, s, c, h, tz & 63);
            v4u xr0[4]; xblock_load<true>(xr0, XBC, 1536, h * 64, s, c, 0, tz & 63);
            stage_rows_st<64, 16>(sc_, F.lds + SC_CIMG, 272, tz); stage_rows_st<128, 16>(sb_, F.lds + SC_BIMG, 272, tz);
            decay_setup(dec, dr.laf0, dr.laf1, dr.lab0, dr.lab1, dr.dtf0, dr.dtf1, dr.dtb0, dr.dtb1, tz & 63, cfe, cbe);
            __syncthreads();
            const bf16* sf = SIN + ((size_t)(cid * NHS + h) * 2) * 8192;
            int ly = F.lane; asm volatile("" : "+v"(ly));
            scanC_job<128>(y, F.lds + SC_CIMG, F.lds + SC_BIMG, xp, dec, cbe, XBC, 1536, h * 64, s, c, lh * 64, a.in[9][layer * 16 + h], sf, sf + 8192, ly, xr0);
            int lz = F.lane; asm volatile("" : "+v"(lz)); const int g = lz >> 4, i = lz & 15;
            v2u zz[4][4]; int rowl[4];
#pragma unroll
            for (int lt = 0; lt < 4; ++lt) { rowl[lt] = chunk_row(s, c, lh * 64 + 16 * lt + i);
#pragma unroll
                for (int pt = 0; pt < 4; ++pt) zz[lt][pt] = rowl[lt] >= 0 ? *(const v2u*)(P + (size_t)rowl[lt] * P_LD + PC_Z + h * 64 + 16 * pt + 4 * g) : (v2u){0u, 0u}; }
#pragma unroll
            for (int lt = 0; lt < 4; ++lt) { float acc = 0.f;
#pragma unroll
                for (int pt = 0; pt < 4; ++pt) { const f32x4 zf = (f32x4){bflo(zz[lt][pt].x), bfhi(zz[lt][pt].x), bflo(zz[lt][pt].y), bfhi(zz[lt][pt].y)};
#pragma unroll
                    for (int r = 0; r < 4; ++r) { const float v = y[lt][pt][r] * siluf(zf[r]); y[lt][pt][r] = v; acc += v * v; } }
                acc += __shfl_xor(acc, 16); acc += __shfl_xor(acc, 32);
                if (g == 0) xch[F.wave * 64 + 16 * lt + i] = acc; }
            __syncthreads();
            const float* nw = a.in[10] + layer * 1024 + h * 64;
#pragma unroll
            for (int lt = 0; lt < 4; ++lt) { float tot = 0.f;
#pragma unroll
                for (int w = 0; w < 8; ++w) tot += xch[w * 64 + 16 * lt + i];
                const float rstd = rsqrtf(tot * (1.f / 512.f) + EPS);
                if (rowl[lt] >= 0) {
#pragma unroll
                    for (int pt = 0; pt < 4; ++pt) { const f32x4 wv = *(const f32x4*)(nw + 16 * pt + 4 * g); const f32x4 o = y[lt][pt] * rstd * wv;
                        *(v2u*)(XN + (size_t)rowl[lt] * D + h * 64 + 16 * pt + 4 * g) = (v2u){pk2(o[0], o[1]), pk2(o[2], o[3])}; } } }
        } else {
            const int hd = F.wave >> 2, vh = (F.wave >> 1) & 1, lh = F.wave & 1, h = sub * 2 + hd;
            v4u sq_[2][2], sk_[2][2];
#pragma unroll
            for (int k = 0; k < 2; ++k) { stage_rows_ld<128, 8>(sq_[k], P, P_LD, PC_RET + (sub * 2 + k) * 64, s, c, 0, tz); stage_rows_ld<128, 8>(sk_[k], P, P_LD, PC_RET + 512 + (sub * 2 + k) * 64, s, c, 0, tz); }
            const DecRaw dr = decay_raw<false>(F, a, layer, s, c, h, tz & 63);
            v4u xr0[4]; xblock_load<true>(xr0, P, P_LD, PC_RET + 1024 + h * 128 + vh * 64, s, c, 0, tz & 63);
#pragma unroll
            for (int k = 0; k < 2; ++k) { stage_rows_st<128, 8>(sq_[k], F.lds + SC_CIMG + k * 18432, 144, tz); stage_rows_st<128, 8>(sk_[k], F.lds + SC_BIMG + k * 18432, 144, tz); }
            decay_setup(dec, dr.laf0, dr.laf1, dr.lab0, dr.lab1, dr.dtf0, dr.dtf1, dr.dtb0, dr.dtb1, tz & 63, cfe, cbe);
            __syncthreads();
            const bf16* sf = SIN + ((size_t)(cid * NHS + 16 + h) * 2) * 8192 + vh * 64 * 64;
            int ly = F.lane; asm volatile("" : "+v"(ly));
            scanC_job<64>(y, F.lds + SC_CIMG + hd * 18432 + lh * 64 * 144, F.lds + SC_BIMG + hd * 18432, xp, dec, cbe, P, P_LD, PC_RET + 1024 + h * 128 + vh * 64, s, c, lh * 64, 0.f, sf, sf + 8192, ly, xr0);
            int lz = F.lane; asm volatile("" : "+v"(lz)); const int g = lz >> 4, i = lz & 15;
            v2u gz[4][4]; int rowl[4]; float sm[4], sq[4];
#pragma unroll
            for (int lt = 0; lt < 4; ++lt) { rowl[lt] = chunk_row(s, c, lh * 64 + 16 * lt + i);
#pragma unroll
                for (int pt = 0; pt < 4; ++pt) gz[lt][pt] = rowl[lt] >= 0 ? *(const v2u*)(P + (size_t)rowl[lt] * P_LD + PC_RET + 2048 + h * 128 + vh * 64 + 16 * pt + 4 * g) : (v2u){0u, 0u}; }
#pragma unroll
            for (int lt = 0; lt < 4; ++lt) { float a1 = 0.f, a2 = 0.f;
#pragma unroll
                for (int pt = 0; pt < 4; ++pt)
#pragma unroll
                    for (int r = 0; r < 4; ++r) { const float v = y[lt][pt][r]; a1 += v; a2 += v * v; }
                a1 += __shfl_xor(a1, 16); a1 += __shfl_xor(a1, 32); a2 += __shfl_xor(a2, 16); a2 += __shfl_xor(a2, 32); sm[lt] = a1; sq[lt] = a2;
                if (g == 0) { xch[(F.wave * 64 + 16 * lt + i) * 2] = a1; xch[(F.wave * 64 + 16 * lt + i) * 2 + 1] = a2; } }
            __syncthreads();
            const int pw = F.wave ^ 2;
#pragma unroll
            for (int lt = 0; lt < 4; ++lt) {
                const float t1 = sm[lt] + xch[(pw * 64 + 16 * lt + i) * 2], t2 = sq[lt] + xch[(pw * 64 + 16 * lt + i) * 2 + 1];
                const float mu = t1 * (1.f / 128.f), var = fmaxf(t2 * (1.f / 128.f) - mu * mu, 0.f), rstd = rsqrtf(var + 1e-5f);
                if (rowl[lt] >= 0) {
#pragma unroll
                    for (int pt = 0; pt < 4; ++pt) { const f32x4 gf = (f32x4){bflo(gz[lt][pt].x), bfhi(gz[lt][pt].x), bflo(gz[lt][pt].y), bfhi(gz[lt][pt].y)}; f32x4 o;
#pragma unroll
                        for (int r = 0; r < 4; ++r) o[r] = (y[lt][pt][r] - mu) * rstd * siluf(gf[r]);
                        *(v2u*)(XN + (size_t)rowl[lt] * D + 3072 + h * 128 + vh * 64 + 16 * pt + 4 * g) = (v2u){pk2(o[0], o[1]), pk2(o[2], o[3])}; } } }
        }
        }
    DYN_LOOP_END(q)
    __syncthreads();
}

constexpr int SW_KB = 0, SW_VB = 34816, SW_BLK = 17408;
__device__ __forceinline__ void swa_blk_load(v4u (&kv)[4], const bf16* P, int s, int kb, int nkb, int grp, int tid) {
#pragma unroll
    for (int q = 0; q < 4; ++q) { const int idx = tid + q * NTHREADS, isv = idx >> 10, r = (idx >> 4) & 63, pc = idx & 15;
        int row; if (kb >= 0) row = seq_start(s) + kb * 64 + r; else row = r < NMETA ? META0 + s * NMETA + r : -1;
        kv[q] = row >= 0 ? *(const v4u*)(P + (size_t)row * P_LD + PC_SWA + 1024 + isv * 256 + grp * 128 + pc * 8) : (v4u){0u, 0u, 0u, 0u}; }
}
__device__ __forceinline__ void swa_blk_store(const v4u (&kv)[4], LAS unsigned char* lds, int buf, int tid) {
#pragma unroll
    for (int q = 0; q < 4; ++q) { const int idx = tid + q * NTHREADS, isv = idx >> 10, r = (idx >> 4) & 63, pc = idx & 15;
        *(LAS v4u*)(lds + (isv ? SW_VB : SW_KB) + buf * SW_BLK + r * 272 + pc * 16) = kv[q]; }
}
__device__ __forceinline__ void swa_unit(const Frame& F, KArgs& a, int layer, int u) {
    const bf16* P = (const bf16*)(F.ws + WS_P);
    bf16* XN = (bf16*)(F.ws + WS_XN);
    constexpr float LOG2E = 1.4426950408889634f;
    {
        int s, qb, grp;
        if (u < 768) { const int ub = u >> 1; grp = u & 1; if (ub < 128) { s = ub >> 6; qb = ub & 63; } else { s = 2 + ((ub - 128) >> 5); qb = (ub - 128) & 31; } }
        else { s = (u - 768) >> 1; grp = u & 1; qb = -1; }
        const int T = seq_T(s), st0 = seq_start(s);
        const int kb_lo = qb < 0 ? 0 : (qb - 2 < 0 ? 0 : qb - 2), kb_hi = qb < 0 ? 1 : (qb + 2 > T / 64 - 1 ? T / 64 - 1 : qb + 2);
        const int nblk = kb_hi - kb_lo + 2;
        int tz = F.tid; asm volatile("" : "+v"(tz));
        const int lane = tz & 63, g = lane >> 4, i = lane & 15;
        const int hr = F.wave >> 1, half = F.wave & 1, hq = grp * 4 + hr;
        const int nq = qb < 0 ? NMETA : 64;
        bf16x8 qf[2][4]; int posq[2];
#pragma unroll
        for (int qt = 0; qt < 2; ++qt) { const int qi = half * 32 + 16 * qt + i; const bool ok = qi < nq; const int qc = ok ? qi : 0;
            const int row = qb < 0 ? META0 + s * NMETA + qc : st0 + qb * 64 + qc; posq[qt] = qb < 0 ? qc : NMETA + qb * 64 + qc;
#pragma unroll
            for (int kk = 0; kk < 4; ++kk) qf[qt][kk] = *(const bf16x8*)(P + (size_t)row * P_LD + PC_SWA + hq * 128 + kk * 32 + 8 * g); }
        const float slope2 = exp2f(-(float)(hq + 1)) * LOG2E, scale2 = 0.08838834764831845f * LOG2E;
        f32x4 O[2][8]; float lp[2] = {0.f, 0.f};
#pragma unroll
        for (int qt = 0; qt < 2; ++qt)
#pragma unroll
            for (int dt = 0; dt < 8; ++dt) O[qt][dt] = (f32x4){0.f, 0.f, 0.f, 0.f};
        v4u kv[4];
        swa_blk_load(kv, P, s, kb_lo, 0, grp, tz);
        __syncthreads();
#pragma unroll 1
        for (int b = 0; b < nblk; ++b) {
            const int buf = b & 1;
            swa_blk_store(kv, F.lds, buf, tz);
            if (b + 1 < nblk) swa_blk_load(kv, P, s, (b + 1 < nblk - 1) ? kb_lo + b + 1 : -1, 0, grp, tz);
            __syncthreads();
            const bool ismeta = (b == nblk - 1);
            const int kpos0 = ismeta ? 0 : NMETA + (kb_lo + b) * 64;
            const LAS unsigned char* kb_ = F.lds + SW_KB + buf * SW_BLK;
            const LAS unsigned char* vb_ = F.lds + SW_VB + buf * SW_BLK;
#pragma unroll
            for (int h2 = 0; h2 < 2; ++h2) {
                if (ismeta && h2 == 1) continue;
                bf16x8 kf0[4], kf1[4];
#pragma unroll
                for (int kk = 0; kk < 4; ++kk) { kf0[kk] = *(const LAS bf16x8*)(kb_ + (h2 * 32 + i) * 272 + (kk * 32 + 8 * g) * 2); kf1[kk] = *(const LAS bf16x8*)(kb_ + (h2 * 32 + 16 + i) * 272 + (kk * 32 + 8 * g) * 2); }
                bf16x8 vf[8];
#pragma unroll
                for (int dt = 0; dt < 8; ++dt) { const LAS unsigned char* ap = vb_ + (h2 * 32 + 4 * g + (i >> 2)) * 272 + (16 * dt + 4 * (i & 3)) * 2; vf[dt] = cat4(lds_tr(ap), lds_tr(ap + 16 * 272)); }
#pragma unroll
                for (int qt = 0; qt < 2; ++qt) {
                    f32x4 t0 = (f32x4){0.f, 0.f, 0.f, 0.f}, t1 = (f32x4){0.f, 0.f, 0.f, 0.f};
#pragma unroll
                    for (int kk = 0; kk < 4; ++kk) { t0 = mfma16(kf0[kk], qf[qt][kk], t0); t1 = mfma16(kf1[kk], qf[qt][kk], t1); }
                    float m[8]; float ls = 0.f;
                    const float dfl = (float)(kpos0 + h2 * 32 + 4 * g - posq[qt]);
                    const bool edge = (qb < 0 || kb_lo + b <= qb - 2 || kb_lo + b >= qb + 2);
                    if (ismeta) {
#pragma unroll
                        for (int r = 0; r < 4; ++r) { const float p0 = (h2 * 32 + 4 * g + r < NMETA) ? __builtin_amdgcn_exp2f(fminf(t0[r] * scale2, 86.f)) : 0.f; m[r] = p0; m[4 + r] = 0.f; ls += p0; }
                    } else {
#pragma unroll
                        for (int r = 0; r < 4; ++r) { const float x0 = dfl + (float)r, x1 = dfl + (float)(r + 16);
                            float p0 = __builtin_amdgcn_exp2f(fminf(t0[r] * scale2 - slope2 * fabsf(x0), 86.f)), p1 = __builtin_amdgcn_exp2f(fminf(t1[r] * scale2 - slope2 * fabsf(x1), 86.f));
                            if (edge) { p0 = fabsf(x0) <= 128.f ? p0 : 0.f; p1 = fabsf(x1) <= 128.f ? p1 : 0.f; }
                            m[r] = p0; m[4 + r] = p1; ls += p0 + p1; }
                    }
                    lp[qt] += ls;
                    const bf16x8 af = pack8(m);
#pragma unroll
                    for (int dt = 0; dt < 8; ++dt) O[qt][dt] = mfma16(vf[dt], af, O[qt][dt]);
                }
                __builtin_amdgcn_sched_barrier(0);
            }
        }
        const float snk = exp2f(a.in[11][layer * 8 + hq] * LOG2E);
        int lz = F.lane; asm volatile("" : "+v"(lz)); const int g2 = lz >> 4, i2 = lz & 15;
#pragma unroll
        for (int qt = 0; qt < 2; ++qt) {
            float l = lp[qt]; l += __shfl_xor(l, 16); l += __shfl_xor(l, 32); l += snk;
            const float inv = __builtin_amdgcn_rcpf(l);
            const int qi = half * 32 + 16 * qt + i2;
            if (qi < nq) { const int row = qb < 0 ? META0 + s * NMETA + qi : st0 + qb * 64 + qi;
#pragma unroll
                for (int dt = 0; dt < 8; ++dt) { const f32x4 o = O[qt][dt] * inv; *(v2u*)(XN + (size_t)row * D + 1024 + hq * 128 + 16 * dt + 4 * g2) = (v2u){pk2(o[0], o[1]), pk2(o[2], o[3])}; } }
        }
    }
}
constexpr int NA_STG = 36864, NA_V = 18432, NA_RPB = 73728;
__device__ __forceinline__ void na_row_load(v4u (&kv)[4], const bf16* P, int s, int kr, int hp, int tid) {
#pragma unroll
    for (int q = 0; q < 4; ++q) { const int idx = tid + q * NTHREADS, isv = idx >> 10, hd = (idx >> 9) & 1, tok = (idx >> 3) & 63, pc = idx & 7;
        int row; if (kr >= 0) row = seq_start(s) + kr * 64 + tok; else row = tok < NMETA ? META0 + s * NMETA + tok : -1;
        kv[q] = row >= 0 ? *(const v4u*)(P + (size_t)row * P_LD + PC_NA + 1024 * (1 + isv) + (hp * 2 + hd) * 64 + pc * 8) : (v4u){0u, 0u, 0u, 0u}; }
}
__device__ __forceinline__ void na_row_store(const v4u (&kv)[4], LAS unsigned char* lds, int buf, int tid) {
#pragma unroll
    for (int q = 0; q < 4; ++q) { const int idx = tid + q * NTHREADS, isv = idx >> 10, hd = (idx >> 9) & 1, tok = (idx >> 3) & 63, pc = idx & 7;
        *(LAS v4u*)(lds + buf * NA_STG + isv * NA_V + hd * 9216 + tok * 144 + pc * 16) = kv[q]; }
}
__device__ __forceinline__ void na_unit(const Frame& F, KArgs& a, int layer, int u) {
    const bf16* P = (const bf16*)(F.ws + WS_P);
    bf16* XN = (bf16*)(F.ws + WS_XN);
    constexpr float LOG2E = 1.4426950408889634f;
    LAS float* rpbl = (LAS float*)(F.lds + NA_RPB);
    {
        int s, R, hp;
        if (u < 768) { hp = u & 7; const int q4 = u >> 3; if (q4 < 32) { s = q4 >> 4; R = (q4 & 15) * 4; } else { s = 2 + ((q4 - 32) >> 3); R = ((q4 - 32) & 7) * 4; } }
        else { hp = (u - 768) & 7; s = (u - 768) >> 3; R = -1; }
        const int T = seq_T(s), st0 = seq_start(s), nrows = T >> 6;
        int tz = F.tid; asm volatile("" : "+v"(tz));
        const int lane = tz & 63, g = lane >> 4, i = lane & 15;
        const int hd = F.wave >> 2, ct = F.wave & 3, h = hp * 2 + hd;
        int kr_lo, kr_hi;
        if (R >= 0) { int a0 = R - 4; a0 = a0 < 0 ? 0 : (a0 > nrows - 8 ? nrows - 8 : a0); int a1 = R + 3 - 4; a1 = a1 < 0 ? 0 : (a1 > nrows - 8 ? nrows - 8 : a1); kr_lo = a0; kr_hi = a1 + 7; }
        else { kr_lo = 0; kr_hi = 7; }
        const int nst = kr_hi - kr_lo + 2;
        const int c0 = 16 * ct, c = c0 + i;
        int cw = c0 - 8; cw = cw < 0 ? 0 : (cw > 32 ? 32 : cw);
        int cs = c - 8; cs = cs < 0 ? 0 : (cs > 48 ? 48 : cs);
        if (R < 0) { cw = 0; cs = 0; }
        const int nqr = R < 0 ? 1 : 4;
        int boff[8];
#pragma unroll
        for (int r = 0; r < 4; ++r) { const int k0 = cw + 4 * g + r, k1 = k0 + 16; const bool v0 = (k0 >= cs && k0 <= cs + 15), v1 = (k1 >= cs && k1 <= cs + 15);
            boff[r] = v0 ? (R >= 0 ? k0 - c + 15 : 0) : 31; boff[4 + r] = v1 ? (R >= 0 ? k1 - c + 15 : 0) : 31; }
        bf16x8 qf[4][2];
#pragma unroll
        for (int qr = 0; qr < 4; ++qr) { int row;
            if (R >= 0) row = st0 + (R + qr) * 64 + c; else row = META0 + s * NMETA + i;
#pragma unroll
            for (int kk = 0; kk < 2; ++kk) qf[qr][kk] = *(const bf16x8*)(P + (size_t)row * P_LD + PC_NA + h * 64 + kk * 32 + 8 * g); }
        f32x4 O[4][4]; float lp[4] = {0.f, 0.f, 0.f, 0.f};
#pragma unroll
        for (int qr = 0; qr < 4; ++qr)
#pragma unroll
            for (int dt = 0; dt < 4; ++dt) O[qr][dt] = (f32x4){0.f, 0.f, 0.f, 0.f};
        v4u kv[4];
        na_row_load(kv, P, s, kr_lo, hp, tz);
        __syncthreads();
        for (int e = tz; e < 2 * 512; e += NTHREADS) { const int hd2 = e >> 9, ro = (e >> 5) & 15, col = e & 31;
            rpbl[e] = col == 31 ? -1e30f : (ro < 15 ? a.in[12][((size_t)layer * 16 + hp * 2 + hd2) * 465 + ro * 31 + col] * LOG2E : 0.f); }
#pragma unroll 1
        for (int b = 0; b < nst; ++b) {
            const int buf = b & 1;
            na_row_store(kv, F.lds, buf, tz);
            if (b + 1 < nst) na_row_load(kv, P, s, (b + 1 < nst - 1) ? kr_lo + b + 1 : -1, hp, tz);
            __syncthreads();
            const bool ismeta = (b == nst - 1);
            const int kr = kr_lo + b;
            const LAS unsigned char* kb_ = F.lds + buf * NA_STG + hd * 9216;
            const LAS unsigned char* vb_ = kb_ + NA_V;
            const int kc0 = ismeta ? 0 : cw;
            bf16x8 kf0[2], kf1[2];
#pragma unroll
            for (int kk = 0; kk < 2; ++kk) { kf0[kk] = *(const LAS bf16x8*)(kb_ + (kc0 + i) * 144 + (kk * 32 + 8 * g) * 2); kf1[kk] = *(const LAS bf16x8*)(kb_ + (kc0 + 16 + i) * 144 + (kk * 32 + 8 * g) * 2); }
            bf16x8 vf[4];
#pragma unroll
            for (int dt = 0; dt < 4; ++dt) { const LAS unsigned char* ap = vb_ + (kc0 + 4 * g + (i >> 2)) * 144 + (16 * dt + 4 * (i & 3)) * 2; vf[dt] = cat4(lds_tr(ap), lds_tr(ap + 16 * 144)); }
#pragma unroll
            for (int qr = 0; qr < 4; ++qr) {
                if (qr >= nqr) continue;
                int r0 = 0, roff = 15;
                if (R >= 0) { r0 = R + qr - 4; r0 = r0 < 0 ? 0 : (r0 > nrows - 8 ? nrows - 8 : r0); roff = kr - (R + qr) + 7; }
                if (!ismeta && (kr < r0 || kr > r0 + 7)) continue;
                f32x4 t0 = (f32x4){0.f, 0.f, 0.f, 0.f}, t1 = (f32x4){0.f, 0.f, 0.f, 0.f};
#pragma unroll
                for (int kk = 0; kk < 2; ++kk) { t0 = mfma16(kf0[kk], qf[qr][kk], t0); t1 = mfma16(kf1[kk], qf[qr][kk], t1); }
                float m[8]; float ls = 0.f;
                if (ismeta) {
#pragma unroll
                    for (int r = 0; r < 4; ++r) { const float p0 = (4 * g + r < NMETA) ? __builtin_amdgcn_exp2f(fminf(t0[r] * (0.125f * LOG2E), 86.f)) : 0.f; m[r] = p0; m[4 + r] = 0.f; ls += p0; }
                } else {
                    const LAS float* bp = rpbl + hd * 512 + roff * 32;
#pragma unroll
                    for (int r = 0; r < 4; ++r) {
                        const float b0 = bp[boff[r]], b1 = bp[boff[4 + r]];
                        const float a0 = t0[r] * (0.125f * LOG2E) + b0, a1 = t1[r] * (0.125f * LOG2E) + b1;
                        const float p0 = __builtin_amdgcn_exp2f(fminf(a0, 86.f)), p1 = __builtin_amdgcn_exp2f(fminf(a1, 86.f));
                        m[r] = p0; m[4 + r] = p1; ls += p0 + p1;
                    }
                }
                lp[qr] += ls;
                const bf16x8 af = pack8(m);
#pragma unroll
                for (int dt = 0; dt < 4; ++dt) O[qr][dt] = mfma16(vf[dt], af, O[qr][dt]);
            }
            __builtin_amdgcn_sched_barrier(0);
        }
        int lz = F.lane; asm volatile("" : "+v"(lz)); const int g2 = lz >> 4, i2 = lz & 15;
#pragma unroll
        for (int qr = 0; qr < 4; ++qr) {
            if (qr >= nqr) continue;
            float l = lp[qr]; l += __shfl_xor(l, 16); l += __shfl_xor(l, 32);
            const float inv = __builtin_amdgcn_rcpf(l);
            int row; bool ok = true;
            if (R >= 0) row = st0 + (R + qr) * 64 + c0 + i2; else { row = META0 + s * NMETA + i2; ok = (ct == 0); }
            if (ok) {
#pragma unroll
                for (int dt = 0; dt < 4; ++dt) { const f32x4 o = O[qr][dt] * inv; *(v2u*)(XN + (size_t)row * D + 2048 + h * 64 + 16 * dt + 4 * g2) = (v2u){pk2(o[0], o[1]), pk2(o[2], o[3])}; } }
        }
    }
}
__device__ __forceinline__ void p_attn(const Frame& F, KArgs& a, int layer) {
    const int NBG = bg_entries(0, layer);
    DYN_LOOP_BEGIN(q, 1636 + NBG, layer * 4 + 0)
        int u; const int be = bg_split(q, 1636, NBG, u);
        if (be >= 0) { bg_entry(F, a, 0, layer, be); } else {
        int su = -1, nu = -1;
        if (u < 768) su = u; else if (u < 1536) nu = u - 768; else if (u < 1556) su = 768 + (u - 1536); else nu = 768 + (u - 1556);
        if (su >= 0) swa_unit(F, a, layer, su); else na_unit(F, a, layer, nu);
        }
    DYN_LOOP_END(q)
    __syncthreads();
}

constexpr int N_PHASES = 22;
__global__ void __launch_bounds__(NTHREADS, 2) fwd_kernel(Args args_v) {
    extern __shared__ __attribute__((aligned(16))) unsigned char lds[];
#define MKFRAME() Frame F; F.lds = (LAS unsigned char*)lds; F.tid = opaque_tid(wave_s); F.lane = F.tid & 63; F.wave = __builtin_amdgcn_readfirstlane(F.tid >> 6); \
    F.G = gridDim.x; F.gw = blockIdx.x * NWAVES + F.wave; F.NGW = F.G * NWAVES; KArgs* kap = (KArgs*)__builtin_amdgcn_kernarg_segment_ptr(); asm volatile("" : "+s"(kap)); KArgs& args = *kap; F.ws = args.ws; F.out = args.out
    LAS unsigned char* const ldsp = (LAS unsigned char*)lds;
#define GEMM_PTRS() KArgs* kap = (KArgs*)__builtin_amdgcn_kernarg_segment_ptr(); asm volatile("" : "+s"(kap)); unsigned char* ws = kap->ws; float* outp = kap->out; (void)outp
    const int wave_s = __builtin_amdgcn_readfirstlane((int)threadIdx.x >> 6);
    volatile LAS unsigned* MISC = (volatile LAS unsigned*)(ldsp + MISC_OFF);
    for (int u = threadIdx.x; u < (LDS_BYTES - LDSCTL_OFF) / 4; u += NTHREADS) ((LAS unsigned*)(ldsp + LDSCTL_OFF))[u] = 0u;
    __syncthreads();
    unsigned* ctl = (unsigned*)(args_v.ws + WS_CTL);
    const bool multi = (args_v.ph_hi - args_v.ph_lo) > 1;
    if (multi) {
        XcdBarrier bar = xcd_barrier_post(ctl + CW_BAR, MISC + 8);
        if (threadIdx.x == 0) { unsigned nloc, nx; xcd_barrier_complete(ctl + CW_BAR, bar.x, nloc, nx); MISC[8] = nloc; MISC[9] = nx; }
        __syncthreads();
    }
#ifndef PHMASK
#define PHMASK 0xFFF
#endif
#define PHM(k) ((PHMASK >> ((k) == 0 ? 0 : ((k) == 21 ? 11 : (((k) - 1) % 10) + 1))) & 1)
#define KAP_() ((KArgs*)__builtin_amdgcn_kernarg_segment_ptr())
#define IN(k) (PHM(k) && KAP_()->ph_lo <= (k) && (k) < KAP_()->ph_hi)
#define BAR_() do { XcdBarrier b_; b_.bar = (unsigned*)(KAP_()->ws + WS_CTL) + CW_BAR; b_.x = xb_xcc_id(); b_.st = (volatile LAS unsigned*)((LAS unsigned char*)lds + MISC_OFF) + 8; xcd_barrier(b_, wave_s == 0 && opaque_lane() == 0); } while (0)
#define SEAM(k) do { if (IN(k) && IN((k) + 1)) BAR_(); } while (0)
#ifndef REPMASK
#define REPMASK 0
#endif
#define REPM(k) ((REPMASK >> ((k) == 0 ? 0 : ((k) == 21 ? 11 : (((k) - 1) % 10) + 1))) & 1)
#define RUN2(k, body) do { { body; } if (REPM(k)) { BAR_(); { body; } } } while (0)
    if (IN(0)) { RUN2(0, MKFRAME(); p_prologue(F, args)); SEAM(0); }
#define LAYER_BODY(layer) do { \
        const int pb = 1 + 10 * layer; \
        if (IN(pb + 0)) { if (layer > 0) { MKFRAME(); p_norm_meta(F, 2 * layer); SEAM(pb + 0); } } \
        if (IN(pb + 1)) { \
            GEMM_PTRS(); \
            pg8::Gemm g{(const bf16*)(ws + WS_HB), (const bf16*)(ws + WS_WIN + layer * SZ_WIN), MP, IN_N, D}; \
            pg8::StaticOrder S; S.init(IN_N, D, 1, (int)gridDim.x, (int)blockIdx.x); \
            pg8::EpiInProj E{(bf16*)(ws + WS_P), (float*)(ws + WS_DT), (const float*)(ws + WS_RSTD) + (size_t)(2 * layer) * MP}; \
            RUN2(pb + 1, (pg8::gemm_phase<pg8::EpiInProj, pg8::StaticOrder, true, true>(ldsp + RING_OFF, g, S, E, wave_s))); \
            SEAM(pb + 1); \
        } \
        if (IN(pb + 2)) { RUN2(pb + 2, { MKFRAME(); p_ssd_prep(F, args, layer); } { MKFRAME(); p_attn(F, args, layer); }); SEAM(pb + 2); } \
        if (IN(pb + 3)) { RUN2(pb + 3, MKFRAME(); p_scanA(F, args, layer)); SEAM(pb + 3); } \
        if (IN(pb + 4)) { RUN2(pb + 4, MKFRAME(); p_scanB(F, args)); SEAM(pb + 4); } \
        if (IN(pb + 5)) { RUN2(pb + 5, MKFRAME(); p_scanC(F, args, layer)); SEAM(pb + 5); } \
        if (IN(pb + 6)) { \
            GEMM_PTRS(); \
            pg8::Gemm g{(const bf16*)(ws + WS_XN), (const bf16*)(ws + WS_WOUT + layer * SZ_WOUT), MP, D, D}; \
            pg8::StaticOrder S; S.init(D, D, 16, (int)gridDim.x, (int)blockIdx.x); \
            pg8::EpiResid E{(bf16*)(ws + WS_HB), (float*)(ws + WS_SLAB), D / 64, (float*)(ws + WS_SSP), nullptr}; \
            pg8::gemm_phase<pg8::EpiResid, pg8::StaticOrder, true, true>(ldsp + RING_OFF, g, S, E, wave_s); \
            SEAM(pb + 6); \
        } \
        if (IN(pb + 7)) { MKFRAME(); p_norm_meta(F, 2 * layer + 1); SEAM(pb + 7); } \
        if (IN(pb + 8)) { \
            GEMM_PTRS(); \
            pg8::Gemm g{(const bf16*)(ws + WS_HB), (const bf16*)(ws + WS_WUP + layer * SZ_WUP), MP, FF, D}; \
            pg8::StaticOrder S; S.init(FF, D, 1, (int)gridDim.x, (int)blockIdx.x); \
            pg8::EpiUp E{(bf16*)(ws + WS_HID), (const float*)(ws + WS_RSTD) + (size_t)(2 * layer + 1) * MP}; \
            RUN2(pb + 8, (pg8::gemm_phase<pg8::EpiUp, pg8::StaticOrder, true, true>(ldsp + RING_OFF, g, S, E, wave_s))); \
            SEAM(pb + 8); \
        } \
        if (IN(pb + 9)) { \
            GEMM_PTRS(); \
            pg8::Gemm g{(const bf16*)(ws + WS_HID), (const bf16*)(ws + WS_WDN + layer * SZ_WDN), MP, D, FF}; \
            pg8::StaticOrder S; S.init(D, FF, 16, (int)gridDim.x, (int)blockIdx.x); \
            pg8::EpiResid E{(bf16*)(ws + WS_HB), (float*)(ws + WS_SLAB), FF / 64, (float*)(ws + WS_SSP), nullptr}; \
            pg8::gemm_phase<pg8::EpiResid, pg8::StaticOrder, true, true>(ldsp + RING_OFF, g, S, E, wave_s); \
            SEAM(pb + 9); \
        } \
     \
    } while (0)
    LAYER_BODY(0);
    LAYER_BODY(1);
#undef LAYER_BODY
    if (IN(21)) { MKFRAME(); p_final_norm(F, args); }
#undef IN
#undef SEAM
}

extern "C" void kernel_launch(void* const* d_in, const int* in_sizes, int n_in, void* d_out, int out_size, void* d_ws, size_t ws_size, hipStream_t stream) {
    static int grid = 0;
    if (grid == 0) {
        if (n_in != 19 || ws_size < WS_END) { fprintf(stderr, "kernel_launch: unexpected shapes (n_in %d, ws %zu, need %zu)\n", n_in, ws_size, (size_t)WS_END); grid = -1; return; }
        int dev = 0, cus = 0, per_cu = 0;
        if (hipGetDevice(&dev) != hipSuccess || hipDeviceGetAttribute(&cus, hipDeviceAttributeMultiprocessorCount, dev) != hipSuccess) { grid = -1; return; }
        if (hipFuncSetAttribute((const void*)fwd_kernel, hipFuncAttributeMaxDynamicSharedMemorySize, LDS_BYTES) != hipSuccess) { fprintf(stderr, "kernel_launch: hipFuncSetAttribute failed\n"); grid = -1; return; }
        if (hipOccupancyMaxActiveBlocksPerMultiprocessor(&per_cu, (const void*)fwd_kernel, NTHREADS, LDS_BYTES) != hipSuccess || per_cu < 1) { fprintf(stderr, "kernel_launch: occupancy query says %d\n", per_cu); }
        (void)hipGetLastError();
        grid = cus;
    }
    if (grid < 0) return;
    (void)hipMemsetAsync((char*)d_ws + WS_CTL, 0, CTL_ZERO_BYTES, stream);
    Args a{};
    for (int i = 0; i < 19; ++i) a.in[i] = (const float*)d_in[i];
    a.out = (float*)d_out; a.ws = (unsigned char*)d_ws;
#if N_LAUNCH_MODE == 1
    a.ph_lo = 0; a.ph_hi = N_PHASES;
    hipLaunchKernelGGL(fwd_kernel, dim3(grid), dim3(NTHREADS), LDS_BYTES, stream, a);
#else
    for (int ph = 0; ph < N_PHASES; ++ph) {
        a.ph_lo = ph; a.ph_hi = ph + 1;
        hipLaunchKernelGGL(fwd_kernel, dim3(grid), dim3(NTHREADS), LDS_BYTES, stream, a);
    }
#endif
}
```

```cpp
#include <hip/hip_runtime.h>
#include <cstdio>
#include <cstdint>

#ifndef N_LAUNCH_MODE
#define N_LAUNCH_MODE 1
#endif

constexpr int D = 4096, FF = 16384;
constexpr int NREAL = 24576, NSEQ = 10, NMETA = 16, MP = 24832;
constexpr int META0 = NREAL;
constexpr int NTOK = NREAL + NSEQ * NMETA;
constexpr int IN_N = 10496, P_LD = 10240;
constexpr int IN_SRC = 10272;
constexpr int PC_Z = 0, PC_XBC = 1024, PC_SWA = 2560, PC_NA = 4096, PC_RET = 7168;
constexpr float EPS = 1e-6f;

constexpr size_t MiB = 1u << 20;
constexpr size_t WS_CTL = 0, CTL_ZERO_BYTES = 65536;
constexpr size_t SZ_WIN = (size_t)IN_N * D * 2, SZ_WOUT = (size_t)D * D * 2, SZ_WUP = (size_t)FF * D * 2, SZ_WDN = (size_t)D * FF * 2;
constexpr size_t WS_WIN = 8 * MiB;
constexpr size_t WS_WOUT = WS_WIN + 2 * SZ_WIN;
constexpr size_t WS_WUP = WS_WOUT + 2 * SZ_WOUT;
constexpr size_t WS_WDN = WS_WUP + 2 * SZ_WUP;
constexpr size_t WS_HM = WS_WDN + 2 * SZ_WDN;
constexpr size_t WS_XN = WS_HM + (size_t)256 * D * 4;
constexpr size_t WS_HB = WS_XN + (size_t)MP * D * 2;
constexpr size_t WS_BIG = WS_HB + (size_t)MP * D * 2;
constexpr size_t WS_P = WS_BIG;
constexpr size_t WS_DT = WS_P + (size_t)MP * P_LD * 2;
constexpr size_t WS_DTL = WS_DT + (size_t)MP * 32 * 4;
constexpr size_t WS_XBC = WS_DTL + (size_t)MP * 64 * 4;
constexpr size_t WS_LOC = WS_XBC + (size_t)MP * 1536 * 2;
constexpr size_t WS_SIN = WS_LOC + (size_t)202 * 24 * 2 * 8192 * 2;
constexpr size_t WS_CDEC = WS_SIN + (size_t)202 * 24 * 2 * 8192 * 2;
constexpr size_t WS_BIG_END1 = WS_CDEC + (size_t)202 * 24 * 2 * 4;
constexpr size_t WS_HID = WS_BIG;
constexpr size_t WS_SLAB = WS_HID + (size_t)MP * FF * 2;
constexpr size_t WS_BIG_END2 = WS_SLAB + (size_t)16 * 256 * D * 4;
constexpr size_t WS_END = WS_BIG_END1 > WS_BIG_END2 ? WS_BIG_END1 : WS_BIG_END2;
static_assert(WS_END <= (size_t)2048 * MiB, "workspace map must fit 2 GiB");

constexpr int CW_BAR = 4096;
constexpr size_t WS_RSTD = 65536;
constexpr size_t WS_SSP = WS_RSTD + (size_t)4 * MP * 4;
static_assert(WS_SSP + (size_t)MP * 64 * 4 <= 8 * MiB, "control region");

constexpr int RING_OFF = 0, RING_BYTES = 131072;
constexpr int LDSCTL_OFF = RING_BYTES, MISC_OFF = LDSCTL_OFF + 320;
constexpr int LDS_BYTES = 147456;
constexpr int NWAVES = 8, NTHREADS = 512;

#define GAS __attribute__((address_space(1)))
#define LAS __attribute__((address_space(3)))
typedef unsigned short bf16;
typedef unsigned v4u __attribute__((ext_vector_type(4)));
typedef unsigned v2u __attribute__((ext_vector_type(2)));
typedef float f32x4 __attribute__((ext_vector_type(4)));
typedef float f32x2 __attribute__((ext_vector_type(2)));
typedef short bf16x8 __attribute__((ext_vector_type(8)));

__device__ __forceinline__ unsigned pk2(float lo, float hi) { unsigned r; asm("v_cvt_pk_bf16_f32 %0, %1, %2" : "=v"(r) : "v"(lo), "v"(hi)); return r; }
__device__ __forceinline__ unsigned f2bf(float f) { return pk2(f, 0.f) & 0xffffu; }
__device__ __forceinline__ float bflo(unsigned w) { return __builtin_bit_cast(float, w << 16); }
__device__ __forceinline__ float bfhi(unsigned w) { return __builtin_bit_cast(float, w & 0xffff0000u); }
__device__ __forceinline__ float bf1(bf16 b) { return __builtin_bit_cast(float, (unsigned)b << 16); }
__device__ __forceinline__ void unpack8(const v4u w, float (&f)[8]) {
    f[0] = bflo(w.x); f[1] = bfhi(w.x); f[2] = bflo(w.y); f[3] = bfhi(w.y); f[4] = bflo(w.z); f[5] = bfhi(w.z); f[6] = bflo(w.w); f[7] = bfhi(w.w);
}
__device__ __forceinline__ float siluf(float x) { return x * __builtin_amdgcn_rcpf(1.f + __expf(-x)); }
__device__ __forceinline__ float wave_sum(float v) {
#pragma unroll
    for (int o = 1; o < 64; o <<= 1) v += __shfl_xor(v, o);
    return v;
}
#define LDS_WAIT() asm volatile("s_waitcnt lgkmcnt(0)" ::: "memory")

__device__ __forceinline__ int seq_start(int s) { return s < 2 ? s * 4096 : 8192 + (s - 2) * 2048; }
__device__ __forceinline__ int seq_T(int s) { return s < 2 ? 4096 : 2048; }
__device__ __forceinline__ int seq_of_real(int r) { return r < 8192 ? (r >> 12) : 2 + ((r - 8192) >> 11); }
__device__ __forceinline__ int row_of(int s, int l) { return l < NMETA ? META0 + s * NMETA + l : seq_start(s) + l - NMETA; }

__device__ __forceinline__ int opaque_lane() { int t; asm volatile("v_mbcnt_lo_u32_b32 %0, -1, 0\n\tv_mbcnt_hi_u32_b32 %0, -1, %0" : "=v"(t)); return t; }
__device__ __forceinline__ int opaque_tid(int wave_s) { return (wave_s << 6) | opaque_lane(); }
namespace pg8 {
#define PG8_LAS __attribute__((address_space(3)))
typedef unsigned short bf16_t;
typedef short bf16x8 __attribute__((ext_vector_type(8)));
typedef float f32x4 __attribute__((ext_vector_type(4)));
typedef unsigned u32x4 __attribute__((ext_vector_type(4)));
constexpr int BM = 256, BK = 64, HALF = 128, HTB = HALF * BK * 2, STAGE_BYTES = 8 * HTB, NXCD = 8, WGM = 8;

__host__ __device__ __forceinline__ int lds_byte(int r, int c) { const int st = (r >> 4) * 2 + (c >> 5), rr = r & 15, cc = c & 31, ob = rr * 64 + cc * 2; return st * 1024 + (ob ^ (((ob >> 9) & 1) << 5)); }
__host__ __device__ __forceinline__ void stage_rc(int b, int& R, int& C) { const int st = b / 1024, sb = b % 1024, swz = sb ^ (((sb >> 9) & 1) << 5); R = (st >> 1) * 16 + swz / 64; C = (st & 1) * 32 + (swz % 64) / 2; }
__host__ __device__ __forceinline__ int perm32(int rho) { const int n = rho >> 4, i = rho & 15; return 8 * (i >> 2) + 4 * n + (i & 3); }

struct Unit { int pm, pn, kt0, nkt; };
struct Gemm { const bf16_t* A; const bf16_t* Bt; int M, N, K; };

struct StaticOrder {
    int nM, nN, nwg, G, c, nt, split;
    __host__ __device__ void init(int N, int K, int split_, int G_, int c_) { nM = 96; nN = N / BM; nwg = nM * nN; G = G_; c = c_; nt = K / BK; split = split_; }
    __host__ __device__ bool next(int i, Unit& u) const {
        const int L = i * G + c;
        if (L >= nwg + nN * split) return false;
        const bool ex = L >= nwg;
        const int e = ex ? L - nwg : 0;
        int wgid = ex ? 0 : L; { const int q = nwg / NXCD, r = nwg % NXCD, xcd = wgid % NXCD, off = wgid / NXCD; wgid = (xcd < r ? xcd * (q + 1) : r * (q + 1) + (xcd - r) * q) + off; }
        const int nig = WGM * nN, gid = wgid / nig, fm = gid * WGM, gsz = (nM - fm) < WGM ? (nM - fm) : WGM;
        int pm_m = fm + ((wgid % nig) % gsz), pn_m = (wgid % nig) / gsz;
        if (nN == 16 && G == 256) {
            const int xcd = c & 7, j = c >> 3; pm_m = 8 * (2 * i + (xcd >> 2)) + (j & 7); pn_m = 4 * (xcd & 3) + (j >> 3); }
        if (nN == 64 && G == 256) {
            const int xcd = c & 7, j = c >> 3; pm_m = 4 * i + (j & 3); pn_m = 8 * xcd + (j >> 2); }
        const int nk_e = nt / split;
        u.pm = ex ? 96 : pm_m; u.pn = ex ? e / split : pn_m; u.nkt = ex ? nk_e : nt; u.kt0 = ex ? (e % split) * nk_e : 0;
        return true;
    }
    __device__ __forceinline__ void a_ready(const Unit&) const {}
    __device__ __forceinline__ void done(const Unit&) const {}
};

__device__ __forceinline__ unsigned cvt_pk_bf16(float lo, float hi) { unsigned r; asm volatile("v_cvt_pk_bf16_f32 %0, %1, %2" : "=v"(r) : "v"(lo), "v"(hi)); return r; }


struct EpiInProj {
    static constexpr bool PERM = true, AFTER_DRAIN = false;
    bf16_t* P; float* DT; const float* rstd;
    static constexpr bool NEED_RS = true;
    __device__ __forceinline__ void operator()(const f32x4 (&acc)[2][2][4][2], const Unit& u, int wr, int wc, const PG8_LAS float* rsl, int) const {
        const int ln = opaque_lane(), fr = ln & 15, fq = ln >> 4;
        const int row0 = u.pm * BM + wr * 64 + fr;
        float rs[2][4];
#pragma unroll
        for (int ai = 0; ai < 2; ++ai)
#pragma unroll
            for (int m = 0; m < 4; ++m) rs[ai][m] = rsl[wr * 64 + fr + ai * HALF + m * 16];
        if (u.pn < 40) {
            const int col0 = u.pn * BM + wc * 32 + 8 * fq;
#pragma unroll
            for (int ai = 0; ai < 2; ++ai)
#pragma unroll
                for (int m = 0; m < 4; ++m) { bf16_t* rowp = P + (size_t)(row0 + ai * HALF + m * 16) * P_LD + col0;
#pragma unroll
                    for (int bj = 0; bj < 2; ++bj) { const f32x4 v0 = acc[ai][bj][m][0] * rs[ai][m], v1 = acc[ai][bj][m][1] * rs[ai][m];
                        u32x4 w; w.x = cvt_pk_bf16(v0[0], v0[1]); w.y = cvt_pk_bf16(v0[2], v0[3]); w.z = cvt_pk_bf16(v1[0], v1[1]); w.w = cvt_pk_bf16(v1[2], v1[3]);
                        *(u32x4*)(rowp + bj * HALF) = w; } }
        } else if (wc == 0) {
#pragma unroll
            for (int ai = 0; ai < 2; ++ai)
#pragma unroll
                for (int m = 0; m < 4; ++m) { float* rowp = DT + (size_t)(row0 + ai * HALF + m * 16) * 32 + 8 * fq;
                    *(f32x4*)(rowp) = acc[ai][0][m][0] * rs[ai][m]; *(f32x4*)(rowp + 4) = acc[ai][0][m][1] * rs[ai][m]; }
        }
    }
};
struct EpiResid {
    static constexpr bool PERM = true, AFTER_DRAIN = false;
    bf16_t* HB; float* slab; int fullkt; float* ssp; const float* rstd;
    static constexpr bool NEED_RS = false;
    __device__ __forceinline__ void operator()(const f32x4 (&acc)[2][2][4][2], const Unit& u, int wr, int wc, const PG8_LAS float*, int) const {
        const int ln = opaque_lane(), fr = ln & 15, fq = ln >> 4;
        const int rloc = wr * 64 + fr, col0 = u.pn * BM + wc * 32 + 8 * fq;
        if (u.nkt == fullkt) {
            u32x4 old[2][4][2];
#pragma unroll
            for (int ai = 0; ai < 2; ++ai)
#pragma unroll
                for (int m = 0; m < 4; ++m) { const bf16_t* hp = HB + (size_t)(u.pm * BM + rloc + ai * HALF + m * 16) * D + col0;
#pragma unroll
                    for (int bj = 0; bj < 2; ++bj) old[ai][m][bj] = *(const u32x4*)(hp + bj * HALF); }
#pragma unroll
            for (int ai = 0; ai < 2; ++ai)
#pragma unroll
                for (int m = 0; m < 4; ++m) { const int row = u.pm * BM + rloc + ai * HALF + m * 16; bf16_t* hp = HB + (size_t)row * D + col0; float sq = 0.f;
#pragma unroll
                    for (int bj = 0; bj < 2; ++bj) { const u32x4 o = old[ai][m][bj];
                        f32x4 v0 = acc[ai][bj][m][0], v1 = acc[ai][bj][m][1];
                        v0[0] += __builtin_bit_cast(float, o.x << 16); v0[1] += __builtin_bit_cast(float, o.x & 0xffff0000u); v0[2] += __builtin_bit_cast(float, o.y << 16); v0[3] += __builtin_bit_cast(float, o.y & 0xffff0000u);
                        v1[0] += __builtin_bit_cast(float, o.z << 16); v1[1] += __builtin_bit_cast(float, o.z & 0xffff0000u); v1[2] += __builtin_bit_cast(float, o.w << 16); v1[3] += __builtin_bit_cast(float, o.w & 0xffff0000u);
                        sq += ((v0[0] * v0[0] + v0[1] * v0[1]) + (v0[2] * v0[2] + v0[3] * v0[3])) + ((v1[0] * v1[0] + v1[1] * v1[1]) + (v1[2] * v1[2] + v1[3] * v1[3]));
                        u32x4 w; w.x = cvt_pk_bf16(v0[0], v0[1]); w.y = cvt_pk_bf16(v0[2], v0[3]); w.z = cvt_pk_bf16(v1[0], v1[1]); w.w = cvt_pk_bf16(v1[2], v1[3]);
                        *(u32x4*)(hp + bj * HALF) = w; }
                    sq += __shfl_xor(sq, 16); sq += __shfl_xor(sq, 32);
                    if (fq == 0) ssp[(size_t)row * 64 + u.pn * 4 + wc] = sq; }
        } else {
            const int ks = u.kt0 / u.nkt;
#pragma unroll
            for (int ai = 0; ai < 2; ++ai)
#pragma unroll
                for (int m = 0; m < 4; ++m) { float* rowp = slab + ((size_t)ks * 256 + rloc + ai * HALF + m * 16) * D + col0;
#pragma unroll
                    for (int bj = 0; bj < 2; ++bj) { *(f32x4*)(rowp + bj * HALF) = acc[ai][bj][m][0]; *(f32x4*)(rowp + bj * HALF + 4) = acc[ai][bj][m][1]; } }
        }
    }
};
struct EpiUp {
    static constexpr bool PERM = true, AFTER_DRAIN = false;
    bf16_t* O; const float* rstd;
    static constexpr bool NEED_RS = true;
    __device__ __forceinline__ void operator()(const f32x4 (&acc)[2][2][4][2], const Unit& u, int wr, int wc, const PG8_LAS float* rsl, int) const {
        const int ln = opaque_lane(), fr = ln & 15, fq = ln >> 4;
        const int row0 = u.pm * BM + wr * 64 + fr, col0 = u.pn * BM + wc * 32 + 8 * fq;
#pragma unroll
        for (int ai = 0; ai < 2; ++ai)
#pragma unroll
            for (int m = 0; m < 4; ++m) { bf16_t* rowp = O + (size_t)(row0 + ai * HALF + m * 16) * FF + col0;
                const float rs = rsl[wr * 64 + fr + ai * HALF + m * 16];
#pragma unroll
                for (int bj = 0; bj < 2; ++bj) { f32x4 v0 = acc[ai][bj][m][0] * rs, v1 = acc[ai][bj][m][1] * rs;
                    v0 = __builtin_elementwise_max(v0, (f32x4){0.f, 0.f, 0.f, 0.f}); v1 = __builtin_elementwise_max(v1, (f32x4){0.f, 0.f, 0.f, 0.f}); v0 = v0 * v0; v1 = v1 * v1;
                    u32x4 w; w.x = cvt_pk_bf16(v0[0], v0[1]); w.y = cvt_pk_bf16(v0[2], v0[3]); w.z = cvt_pk_bf16(v1[0], v1[1]); w.w = cvt_pk_bf16(v1[2], v1[3]);
                    *(u32x4*)(rowp + bj * HALF) = w; } }
    }
};

template <class Epi, class Sched, bool ALIGN_EPI = false, bool SP2 = false>
__device__ __forceinline__ void gemm_phase(PG8_LAS unsigned char* lds, const Gemm g, const Sched& S, const Epi& E, int wave_s) {
    const int tid = opaque_tid(wave_s), wid = __builtin_amdgcn_readfirstlane(tid >> 6), lane = tid & 63, wr = wid >> 2, wc = wid & 3, fr = lane & 15, fq = lane >> 4;
    const int K = g.K;
    unsigned voffA[2], voffB[2];
#pragma unroll
    for (int i = 0; i < 2; ++i) { int R, C; stage_rc(tid * 16 + i * 8192, R, C); const int Rb = Epi::PERM ? ((R & ~31) + perm32(R & 31)) : R;
        voffA[i] = (unsigned)(R * K + C) * 2u; voffB[i] = (unsigned)(Rb * K + C) * 2u; }
    const size_t kstep = (size_t)(BK * 2);
    const size_t hstep = (size_t)HALF * K * 2;
    const size_t tstep = 2 * hstep;
    const unsigned ldsw = (unsigned)wid * 1024u;
    const int aoff = lds_byte(wr * 64 + fr, fq * 8), boff = lds_byte(wc * 32 + fr, fq * 8);
#define PG8_SA(b, h) (((b) * 2 + (h)) * HTB)
#define PG8_SB(b, h) ((4 + (b) * 2 + (h)) * HTB)
#define PG8_STAGE(bufoff, gbase, voff) do { _Pragma("unroll") for (int _i = 0; _i < 2; ++_i) \
        __builtin_amdgcn_global_load_lds((const unsigned*)((const char*)(gbase) + (voff)[_i]), (PG8_LAS unsigned*)(lds + (bufoff) + ldsw + _i * 8192), 16, 0, 0); } while (0)
#define PG8_LDA(dst, b, h) do { _Pragma("unroll") for (int m = 0; m < 4; ++m) _Pragma("unroll") for (int k = 0; k < 2; ++k) dst[m][k] = *(const PG8_LAS bf16x8*)(lds + PG8_SA(b, h) + aoff + m * 2048 + k * 1024); } while (0)
#define PG8_LDB(dst, b, h) do { _Pragma("unroll") for (int n = 0; n < 2; ++n) _Pragma("unroll") for (int k = 0; k < 2; ++k) dst[n][k] = *(const PG8_LAS bf16x8*)(lds + PG8_SB(b, h) + boff + n * 2048 + k * 1024); } while (0)
#define PG8_MMA(ai, bj, At, Bt) do { __builtin_amdgcn_s_setprio(1); _Pragma("unroll") for (int m = 0; m < 4; ++m) _Pragma("unroll") for (int n = 0; n < 2; ++n) _Pragma("unroll") for (int k = 0; k < 2; ++k) \
        acc[ai][bj][m][n] = __builtin_amdgcn_mfma_f32_16x16x32_bf16(Bt[n][k], At[m][k], acc[ai][bj][m][n], 0, 0, 0); __builtin_amdgcn_s_setprio(0); } while (0)
#define PG8_WAIT_V(n) asm volatile("s_waitcnt vmcnt(" #n ")" ::: "memory")
#define PG8_WAIT_L(n) asm volatile("s_waitcnt lgkmcnt(" #n ")" ::: "memory")
#define PG8_BAR __builtin_amdgcn_s_barrier()
#define PG8_SCHED __builtin_amdgcn_sched_barrier(0)
    Unit cur, nxt; int ui = 0;
    if (!S.next(0, cur)) return;
    f32x4 acc[2][2][4][2];
#pragma unroll
    for (int a = 0; a < 2; ++a)
#pragma unroll
        for (int b = 0; b < 2; ++b)
#pragma unroll
            for (int m = 0; m < 4; ++m)
#pragma unroll
                for (int n = 0; n < 2; ++n) acc[a][b][m][n] = (f32x4){0.f, 0.f, 0.f, 0.f};
    bf16x8 At[4][2], B0[2][2], B1[2][2];
    const char* cA = (const char*)g.A + (size_t)cur.pm * tstep + (size_t)cur.kt0 * kstep; const char* cB = (const char*)g.Bt + (size_t)cur.pn * tstep + (size_t)cur.kt0 * kstep;
    S.a_ready(cur);
    if constexpr (SP2) {
        PG8_STAGE(PG8_SB(0, 0), cB, voffB); PG8_STAGE(PG8_SB(0, 1), cB + hstep, voffB); PG8_STAGE(PG8_SA(0, 0), cA, voffA); PG8_STAGE(PG8_SA(0, 1), cA + hstep, voffA);
        if (wr == 1) PG8_BAR;
        PG8_WAIT_V(2); PG8_BAR;
        PG8_STAGE(PG8_SB(1, 0), cB + kstep, voffB); PG8_STAGE(PG8_SA(1, 0), cA + kstep, voffA); PG8_STAGE(PG8_SB(1, 1), cB + hstep + kstep, voffB);
        PG8_WAIT_V(6); PG8_BAR;
    } else {
        PG8_STAGE(PG8_SB(0, 0), cB, voffB); PG8_STAGE(PG8_SA(0, 0), cA, voffA); PG8_STAGE(PG8_SB(0, 1), cB + hstep, voffB); PG8_STAGE(PG8_SA(0, 1), cA + hstep, voffA);
        if (wr == 1) PG8_BAR;
        PG8_WAIT_V(4); PG8_BAR;
        PG8_STAGE(PG8_SB(1, 0), cB + kstep, voffB); PG8_STAGE(PG8_SA(1, 0), cA + kstep, voffA); PG8_STAGE(PG8_SB(1, 1), cB + hstep + kstep, voffB);
        PG8_WAIT_V(6); PG8_BAR;
    }
    for (;;) {
        const bool has_next = S.next(ui + 1, nxt);
        const char* nA = has_next ? (const char*)g.A + (size_t)nxt.pm * tstep + (size_t)nxt.kt0 * kstep : cA; const char* nB = has_next ? (const char*)g.Bt + (size_t)nxt.pn * tstep + (size_t)nxt.kt0 * kstep : cB;
        const int nt = cur.nkt;
        PG8_LAS float* rsl = (PG8_LAS float*)(lds + STAGE_BYTES + 2048 + (ui & 1) * 1024);
        for (int t = 0; t < nt; t += 2) {
            const bool last = (t == nt - 2);
            if constexpr (Epi::NEED_RS) { if (t == 0 && wid < 4) __builtin_amdgcn_global_load_lds((const unsigned*)(E.rstd + cur.pm * BM + wid * 64 + lane), (PG8_LAS unsigned*)(rsl + wid * 64), 4, 0, 0); }
            const char* a1 = cA + (size_t)(t + 1) * kstep;
            const char* a2 = last ? nA : cA + (size_t)(t + 2) * kstep; const char* b2 = last ? nB : cB + (size_t)(t + 2) * kstep;
            const char* a3 = a2 + kstep; const char* b3 = b2 + kstep;
            if (last && has_next) S.a_ready(nxt);
            if constexpr (SP2) {
            PG8_LDB(B0, 0, 0); PG8_LDB(B1, 0, 1); PG8_SCHED; PG8_LDA(At, 0, 0); PG8_STAGE(PG8_SA(1, 1), a1 + hstep, voffA);
            PG8_WAIT_V(8); PG8_WAIT_L(0); PG8_BAR; PG8_MMA(0, 0, At, B0); PG8_MMA(0, 1, At, B1); PG8_BAR; PG8_SCHED;
            PG8_LDA(At, 0, 1); PG8_STAGE(PG8_SB(0, 0), b2, voffB); PG8_STAGE(PG8_SB(0, 1), b2 + hstep, voffB); PG8_STAGE(PG8_SA(0, 0), a2, voffA);
            PG8_WAIT_V(8); PG8_WAIT_L(0); PG8_BAR; PG8_MMA(1, 0, At, B0); PG8_MMA(1, 1, At, B1); PG8_BAR; PG8_SCHED;
            PG8_LDB(B0, 1, 0); PG8_LDB(B1, 1, 1); PG8_SCHED; PG8_LDA(At, 1, 0); PG8_STAGE(PG8_SA(0, 1), a2 + hstep, voffA);
            PG8_WAIT_V(8); PG8_WAIT_L(0); PG8_BAR; PG8_MMA(0, 0, At, B0); PG8_MMA(0, 1, At, B1); PG8_BAR; PG8_SCHED;
            PG8_LDA(At, 1, 1); PG8_STAGE(PG8_SB(1, 0), b3, voffB); PG8_STAGE(PG8_SB(1, 1), b3 + hstep, voffB); PG8_STAGE(PG8_SA(1, 0), a3, voffA);
            PG8_WAIT_V(8); PG8_WAIT_L(0); PG8_BAR; PG8_MMA(1, 0, At, B0); PG8_MMA(1, 1, At, B1); PG8_BAR; PG8_SCHED;
            } else {
            PG8_LDB(B0, 0, 0); PG8_SCHED; PG8_LDA(At, 0, 0); PG8_STAGE(PG8_SA(1, 1), a1 + hstep, voffA);
            PG8_WAIT_L(8); PG8_BAR; PG8_WAIT_L(0); PG8_MMA(0, 0, At, B0); PG8_BAR; PG8_SCHED;
            PG8_LDB(B1, 0, 1); PG8_STAGE(PG8_SB(0, 0), b2, voffB);
            PG8_BAR; PG8_WAIT_L(0); PG8_MMA(0, 1, At, B1); PG8_BAR;
            PG8_LDA(At, 0, 1); PG8_STAGE(PG8_SA(0, 0), a2, voffA);
            PG8_BAR; PG8_WAIT_L(0); PG8_MMA(1, 0, At, B0); PG8_BAR; PG8_SCHED;
            PG8_STAGE(PG8_SB(0, 1), b2 + hstep, voffB);
            PG8_WAIT_V(6); PG8_BAR; PG8_MMA(1, 1, At, B1); PG8_BAR;
            PG8_LDB(B0, 1, 0); PG8_SCHED; PG8_LDA(At, 1, 0); PG8_STAGE(PG8_SA(0, 1), a2 + hstep, voffA);
            PG8_WAIT_L(8); PG8_BAR; PG8_WAIT_L(0); PG8_MMA(0, 0, At, B0); PG8_BAR; PG8_SCHED;
            PG8_LDB(B1, 1, 1); PG8_STAGE(PG8_SB(1, 0), b3, voffB);
            PG8_BAR; PG8_WAIT_L(0); PG8_MMA(0, 1, At, B1); PG8_BAR;
            PG8_LDA(At, 1, 1); PG8_STAGE(PG8_SA(1, 0), a3, voffA);
            PG8_BAR; PG8_WAIT_L(0); PG8_MMA(1, 0, At, B0); PG8_BAR; PG8_SCHED;
            PG8_STAGE(PG8_SB(1, 1), b3 + hstep, voffB);
            PG8_WAIT_V(6); PG8_BAR; PG8_MMA(1, 1, At, B1); PG8_BAR;
            }
        }
        if constexpr (ALIGN_EPI) { if (wr == 0) PG8_BAR; }
        E(acc, cur, wr, wc, rsl, 0); S.done(cur);
        if (!has_next) break;
#pragma unroll
        for (int a = 0; a < 2; ++a)
#pragma unroll
            for (int b = 0; b < 2; ++b)
#pragma unroll
                for (int m = 0; m < 4; ++m)
#pragma unroll
                    for (int n = 0; n < 2; ++n) acc[a][b][m][n] = (f32x4){0.f, 0.f, 0.f, 0.f};
        cur = nxt; cA = nA; cB = nB; ++ui;
        if constexpr (ALIGN_EPI) { if (wr == 1) PG8_BAR; }
    }
    PG8_WAIT_V(0);
    if constexpr (!ALIGN_EPI) { if (wr == 0) PG8_BAR; }
    PG8_BAR;
#undef PG8_SA
#undef PG8_SB
#undef PG8_STAGE
#undef PG8_LDA
#undef PG8_LDB
#undef PG8_MMA
#undef PG8_WAIT_V
#undef PG8_WAIT_L
#undef PG8_BAR
#undef PG8_SCHED
}
}

#define XB_TMO      128
#define XB_XCNT(j)  (256  + 64 * (j))
#define XB_XSUB(j)  (1280 + 64 * (j))
#define XB_XGEN(j)  (2304 + 64 * (j))
#define XB_TOP      3328
#define XB_TOPGEN   3392
#define XCD_BAR_WORDS 3456
#define XB_SPIN_CAP (1u << 18)

__device__ __forceinline__ unsigned xb_ld(unsigned* p)              { return __hip_atomic_load(p, __ATOMIC_RELAXED, __HIP_MEMORY_SCOPE_AGENT); }
__device__ __forceinline__ unsigned xb_add(unsigned* p, unsigned v) { return __hip_atomic_fetch_add(p, v, __ATOMIC_RELAXED, __HIP_MEMORY_SCOPE_AGENT); }
__device__ __forceinline__ unsigned xb_xcc_id() { return (unsigned)__builtin_amdgcn_s_getreg((3 << 11) | 20) & 0xFu; }
#define XB_SPIN(cond, bar) do { unsigned _sp = 0; while (cond) { __builtin_amdgcn_s_sleep(1); \
    if ((++_sp & 255u) == 0u) { if (xb_ld(&(bar)[XB_TMO])) break; if (_sp > XB_SPIN_CAP) { atomicAdd(&(bar)[XB_TMO], 1u); break; } } } } while (0)

struct XcdBarrier {
    unsigned* bar; unsigned x;
    volatile LAS unsigned* st;
};
__device__ __forceinline__ XcdBarrier xcd_barrier_post(unsigned* bar, volatile LAS unsigned* st) {
    XcdBarrier b; b.bar = bar; b.x = xb_xcc_id(); b.st = st;
    if (threadIdx.x == 0) (void)xb_add(&bar[XB_XCNT(b.x)], 1u);
    return b;
}
__device__ __forceinline__ void xcd_barrier_complete(unsigned* bar, unsigned x, unsigned& nloc, unsigned& nx) {
    const unsigned G = gridDim.x * gridDim.y * gridDim.z;
    unsigned sum, cnt, mine, sp = 0u;
    for (;;) {
        sum = 0u; cnt = 0u; mine = 0u;
#pragma unroll
        for (unsigned j = 0; j < 16; ++j) { const unsigned c = xb_ld(&bar[XB_XCNT(j)]); sum += c; cnt += (c > 0u) ? 1u : 0u; mine = (j == x) ? c : mine; }
        if (sum == G) break;
        __builtin_amdgcn_s_sleep(1);
        if ((++sp & 255u) == 0u) { if (xb_ld(&bar[XB_TMO])) break; if (sp > XB_SPIN_CAP) { atomicAdd(&bar[XB_TMO], 1u); break; } }
    }
    nloc = mine > 0u ? mine : 1u; nx = cnt > 0u ? cnt : 1u;
}
__device__ __forceinline__ void xcd_barrier(const XcdBarrier& b, bool leader) {
    asm volatile("s_waitcnt vmcnt(0)" ::: "memory");
    __syncthreads();
    if (leader) {
        unsigned* bar = b.bar;
        __builtin_amdgcn_s_waitcnt(0);
        unsigned nloc = b.st[0], nx = b.st[1];
        const unsigned old = xb_add(&bar[XB_XSUB(b.x)], 1u);
        const unsigned gen = old / nloc;
        if (old + 1u == (gen + 1u) * nloc) {
            __builtin_amdgcn_fence(__ATOMIC_RELEASE, "agent");
            asm volatile("s_waitcnt vmcnt(0)" ::: "memory");
            const unsigned og = xb_add(&bar[XB_TOP], 1u);
            const unsigned tg = og / nx;
            if (og + 1u == (tg + 1u) * nx) xb_add(&bar[XB_TOPGEN], 1u);
            else XB_SPIN(xb_ld(&bar[XB_TOPGEN]) == tg, bar);
            __builtin_amdgcn_fence(__ATOMIC_ACQUIRE, "agent");
            xb_add(&bar[XB_XGEN(b.x)], 1u);
            asm volatile("s_waitcnt vmcnt(0)" ::: "memory");
        } else {
            XB_SPIN(xb_ld(&bar[XB_XGEN(b.x)]) == gen, bar);
            __builtin_amdgcn_fence(__ATOMIC_ACQUIRE, "agent");
            asm volatile("s_waitcnt vmcnt(0)" ::: "memory");
        }
    }
    __syncthreads();
}

struct Args {
    const float* in[19];
    float* out;
    unsigned char* ws;
    int ph_lo, ph_hi;
};
typedef const Args __attribute__((address_space(4))) KArgs;
struct Frame {
    LAS unsigned char* lds;
    unsigned char* ws; float* out;
    int tid, lane, wave, G, gw, NGW;
};

constexpr int CW_DQ = 8192;
constexpr int DQ_LDS = LDSCTL_OFF;
#define DYN_LOOP_BEGIN(u, NU, qid) { unsigned* dq_ctr_ = (unsigned*)(F.ws + WS_CTL) + CW_DQ + 64 * (qid); volatile LAS int* dq_l_ = (volatile LAS int*)(F.lds + DQ_LDS); \
    __syncthreads(); if (F.tid == 0) *dq_l_ = (int)__hip_atomic_fetch_add(dq_ctr_, 1u, __ATOMIC_RELAXED, __HIP_MEMORY_SCOPE_AGENT); __syncthreads(); int u = *dq_l_; \
    while (u < (NU)) { int dq_n_ = 0; if (F.tid == 0) dq_n_ = (int)__hip_atomic_fetch_add(dq_ctr_, 1u, __ATOMIC_RELAXED, __HIP_MEMORY_SCOPE_AGENT);
#define DYN_LOOP_END(u) __syncthreads(); if (F.tid == 0) *dq_l_ = dq_n_; __syncthreads(); u = *dq_l_; } }

__device__ __forceinline__ void transpose_item(const float* W, int K, int Nsrc, const float* kscale, bf16* WT, int k0, int ns0, int nd0, LAS float* scr, int lane) {
    if (ns0 >= 0) {
        float v[32];
#pragma unroll
        for (int i = 0; i < 32; ++i) { const int kk = 2 * i + (lane >> 5); v[i] = W[(size_t)(k0 + kk) * Nsrc + ns0 + (lane & 31)]; }
        if (kscale) {
#pragma unroll
            for (int i = 0; i < 32; ++i) { const int kk = 2 * i + (lane >> 5); v[i] *= kscale[k0 + kk]; } }
#pragma unroll
        for (int i = 0; i < 32; ++i) { const int kk = 2 * i + (lane >> 5); scr[kk * 33 + (lane & 31)] = v[i]; }
    } else {
#pragma unroll 8
        for (int i = 0; i < 32; ++i) { const int kk = 2 * i + (lane >> 5); scr[kk * 33 + (lane & 31)] = 0.f; }
    }
    LDS_WAIT(); asm volatile("" ::: "memory");
    const int c = lane & 7;
#pragma unroll
    for (int j = 0; j < 4; ++j) { const int n = (lane >> 3) + 8 * j; const LAS float* s = scr + (8 * c) * 33 + n;
        v4u o; o.x = pk2(s[0 * 33], s[1 * 33]); o.y = pk2(s[2 * 33], s[3 * 33]); o.z = pk2(s[4 * 33], s[5 * 33]); o.w = pk2(s[6 * 33], s[7 * 33]);
        *(v4u*)(WT + (size_t)(nd0 + n) * K + k0 + 8 * c) = o; }
    LDS_WAIT(); asm volatile("" ::: "memory");
}

constexpr int I_IN = (D / 64) * (IN_N / 32), I_OUT = (D / 64) * (D / 32), I_UP = (D / 64) * (FF / 32), I_DN = (FF / 64) * (D / 32);
__device__ __forceinline__ void convert_item(const Frame& F, KArgs& a, int m, int layer, int r, LAS float* scr, int lane) {
    unsigned char* ws = F.ws;
    if (m == 0) { const int nblk = IN_N / 32, kb = r / nblk, nb = r % nblk, nd0 = nb * 32;
        const int ns0 = nd0 < 2560 ? nd0 : (nd0 < 10240 ? nd0 + 32 : (nd0 < 10272 ? 2560 : -1));
        transpose_item(a.in[4] + (size_t)layer * D * IN_SRC, D, IN_SRC, a.in[3] + layer * D, (bf16*)(ws + WS_WIN + layer * SZ_WIN), kb * 64, ns0, nd0, scr, lane); }
    else if (m == 1) { const int nblk = D / 32, kb = r / nblk, nb = r % nblk;
        transpose_item(a.in[14] + (size_t)layer * D * D, D, D, nullptr, (bf16*)(ws + WS_WOUT + layer * SZ_WOUT), kb * 64, nb * 32, nb * 32, scr, lane); }
    else if (m == 2) { const int nblk = FF / 32, kb = r / nblk, nb = r % nblk;
        transpose_item(a.in[16] + (size_t)layer * D * FF, D, FF, a.in[15] + layer * D, (bf16*)(ws + WS_WUP + layer * SZ_WUP), kb * 64, nb * 32, nb * 32, scr, lane); }
    else { const int nblk = D / 32, kb = r / nblk, nb = r % nblk;
        transpose_item(a.in[17] + (size_t)layer * FF * D, FF, D, nullptr, (bf16*)(ws + WS_WDN + layer * SZ_WDN), kb * 64, nb * 32, nb * 32, scr, lane); }
}
__device__ __forceinline__ int bg_entries(int list, int layer) { return list == 0 ? I_UP / 64 : (list == 1 ? I_OUT / 64 : (layer == 0 ? (I_DN + I_IN) / 64 : I_DN / 64)); }
__device__ __forceinline__ void bg_entry(const Frame& F, KArgs& a, int list, int layer, int e) {
    __syncthreads();
    LAS float* scr = (LAS float*)(F.lds + RING_OFF + F.wave * 16384);
    const int ln = opaque_lane();
#pragma unroll 1
    for (int j = 0; j < 8; ++j) { const int r = e * 64 + F.wave * 8 + j;
        if (list == 0) convert_item(F, a, 2, layer, r, scr, ln);
        else if (list == 1) convert_item(F, a, 1, layer, r, scr, ln);
        else { if (r < I_DN) convert_item(F, a, 3, layer, r, scr, ln); else convert_item(F, a, 0, layer + 1, r - I_DN, scr, ln); } }
}
__device__ __forceinline__ int bg_split(int q, int NU, int NB, int& unit) { const int T = NU + NB, b0 = (q * NB) / T, b1 = ((q + 1) * NB) / T; unit = q - b0; return b1 > b0 ? b0 : -1; }

__device__ __forceinline__ void p_prologue(const Frame& F, KArgs& a) {
    LAS float* scr = (LAS float*)(F.lds + RING_OFF + F.wave * 16384);
    unsigned char* ws = F.ws;
    for (int it = F.gw; it < I_IN; it += F.NGW) convert_item(F, a, 0, 0, it, scr, F.lane);
    float* hm = (float*)(ws + WS_HM);
    bf16* XN = (bf16*)(ws + WS_HB);
    float* rs0 = (float*)(ws + WS_RSTD);
    for (int row = F.gw; row < MP; row += F.NGW) {
        v2u* o = (v2u*)(XN + (size_t)row * D);
        if (row >= NTOK) {
            float* dst = hm + (size_t)(row - NREAL) * D;
            v2u* xm = (v2u*)((bf16*)(ws + WS_XN) + (size_t)row * D);
#pragma unroll
            for (int j = 0; j < 16; ++j) { ((f32x4*)dst)[F.lane + 64 * j] = (f32x4){0.f, 0.f, 0.f, 0.f}; o[F.lane + 64 * j] = (v2u){0u, 0u}; xm[F.lane + 64 * j] = (v2u){0u, 0u}; }
            if (F.lane == 0) rs0[row] = 0.f;
            continue; }
        const f32x4* src; float* dst;
        if (row < NREAL) { src = (const f32x4*)((row < 8192 ? a.in[0] + (size_t)row * D : a.in[1] + (size_t)(row - 8192) * D)); dst = nullptr; }
        else { src = (const f32x4*)(a.in[2] + (size_t)((row - NREAL) & 15) * D); dst = hm + (size_t)(row - NREAL) * D; }
        float sq = 0.f;
#pragma unroll
        for (int j = 0; j < 16; ++j) { const f32x4 v = src[F.lane + 64 * j];
            if (dst) ((f32x4*)dst)[F.lane + 64 * j] = v;
            o[F.lane + 64 * j] = (v2u){pk2(v.x, v.y), pk2(v.z, v.w)}; sq += (v.x * v.x + v.y * v.y) + (v.z * v.z + v.w * v.w); }
        sq = wave_sum(sq);
        if (F.lane == 0) rs0[row] = rsqrtf(sq * (1.f / D) + EPS);
    }
}

__device__ __forceinline__ void p_norm_meta(const Frame& F, int k) {
    float* hm = (float*)(F.ws + WS_HM);
    const float* slab = (const float*)(F.ws + WS_SLAB);
    bf16* XN = (bf16*)(F.ws + WS_HB);
    float* rs = (float*)(F.ws + WS_RSTD) + (size_t)k * MP;
    const float* ssp = (const float*)(F.ws + WS_SSP);
    for (int row = F.gw * 4; row < NREAL; row += F.NGW * 4) {
        float t[4];
#pragma unroll
        for (int j = 0; j < 4; ++j) t[j] = ssp[(size_t)(row + j) * 64 + F.lane];
#pragma unroll
        for (int j = 0; j < 4; ++j) t[j] = wave_sum(t[j]);
        if (F.lane == 0) {
#pragma unroll
            for (int j = 0; j < 4; ++j) rs[row + j] = rsqrtf(t[j] * (1.f / D) + EPS); } }
    for (int mr = F.gw; mr < 256; mr += F.NGW) {
        const int row = NREAL + mr;
        v2u* o = (v2u*)(XN + (size_t)row * D);
        if (F.lane == 0) rs[row] = 1.f;
        if (mr >= NSEQ * NMETA) {
#pragma unroll
            for (int j = 0; j < 16; ++j) o[F.lane + 64 * j] = (v2u){0u, 0u};
            continue; }
        f32x4* src = (f32x4*)(hm + (size_t)mr * D);
        f32x4 v[16]; float sq = 0.f;
#pragma unroll
        for (int j = 0; j < 16; ++j) v[j] = src[F.lane + 64 * j];
#pragma unroll 1
        for (int ks = 0; ks < 16; ++ks) { const f32x4* sp = (const f32x4*)(slab + ((size_t)ks * 256 + mr) * D);
#pragma unroll
            for (int j = 0; j < 16; ++j) v[j] = v[j] + sp[F.lane + 64 * j]; }
#pragma unroll
        for (int j = 0; j < 16; ++j) { src[F.lane + 64 * j] = v[j]; sq += (v[j].x * v[j].x + v[j].y * v[j].y) + (v[j].z * v[j].z + v[j].w * v[j].w); }
        const float rstd = rsqrtf(wave_sum(sq) * (1.f / D) + EPS);
#pragma unroll
        for (int j = 0; j < 16; ++j) o[F.lane + 64 * j] = (v2u){pk2(v[j].x * rstd, v[j].y * rstd), pk2(v[j].z * rstd, v[j].w * rstd)};
    }
}
__device__ __forceinline__ void p_final_norm(const Frame& F, KArgs& a) {
    const f32x4* w = (const f32x4*)a.in[18];
    const float* ssp = (const float*)(F.ws + WS_SSP);
    const bf16* HB = (const bf16*)(F.ws + WS_HB);
    for (int row0 = F.gw * 2; row0 < NREAL; row0 += F.NGW * 2) {
        v2u hv[2][16]; float sp[2];
#pragma unroll
        for (int q = 0; q < 2; ++q) { const v2u* hsrc = (const v2u*)(HB + (size_t)(row0 + q) * D); sp[q] = ssp[(size_t)(row0 + q) * 64 + F.lane];
#pragma unroll
            for (int j = 0; j < 16; ++j) hv[q][j] = hsrc[F.lane + 64 * j]; }
#pragma unroll
        for (int q = 0; q < 2; ++q) { f32x4* p = (f32x4*)(F.out + (size_t)(row0 + q) * D);
            const float rstd = rsqrtf(wave_sum(sp[q]) * (1.f / D) + EPS);
#pragma unroll
            for (int j = 0; j < 16; ++j) { const f32x4 v = (f32x4){bflo(hv[q][j].x), bfhi(hv[q][j].x), bflo(hv[q][j].y), bfhi(hv[q][j].y)}; p[F.lane + 64 * j] = v * rstd * w[F.lane + 64 * j]; } }
    }
}

__device__ __forceinline__ void p_ssd_prep(const Frame& F, KArgs& a, int layer) {
    const bf16* P = (const bf16*)(F.ws + WS_P);
    const float* DT = (const float*)(F.ws + WS_DT);
    float* DTL = (float*)(F.ws + WS_DTL);
    bf16* XBC = (bf16*)(F.ws + WS_XBC);
    const float* cw = a.in[5] + (size_t)layer * 5 * 1536;
    const float* cb = a.in[6] + (size_t)layer * 1536;
    const int NW3 = F.NGW / 3;
    if (F.gw >= 3 * NW3) return;
    const int cc = F.gw % 3, k0 = F.gw / 3;
    const int c0 = cc * 512 + F.lane * 8;
    float wgt[5][8], bias[8];
#pragma unroll
    for (int i = 0; i < 8; ++i) bias[i] = cb[c0 + i];
#pragma unroll
    for (int j = 0; j < 5; ++j)
#pragma unroll
        for (int i = 0; i < 8; ++i) wgt[j][i] = cw[j * 1536 + c0 + i];
    const int dl = F.lane & 31, dp = F.lane >> 5;
    const float dtb = a.in[7][layer * 32 + dl], aexp = __expf(a.in[8][layer * 32 + dl]);
    constexpr int RL = 16, NROW = RL + 4, RUNS_P = 257, RUNS_S = 129;
    constexpr int NRUN = 2 * RUNS_P + 8 * RUNS_S;
#pragma unroll 1
    for (int run = k0; run < NRUN; run += NW3) {
        int s, l0;
        if (run < 2 * RUNS_P) { s = run / RUNS_P; l0 = (run - s * RUNS_P) * RL; } else { const int q = run - 2 * RUNS_P; s = 2 + q / RUNS_S; l0 = (q - (s - 2) * RUNS_S) * RL; }
        const int L = seq_T(s) + NMETA;
        v4u rw[NROW];
#pragma unroll
        for (int j = 0; j < NROW; ++j) { const int lj = l0 - 2 + j; const bool ok = lj >= 0 && lj < L;
            rw[j] = ok ? *(const v4u*)(P + (size_t)row_of(s, lj) * P_LD + PC_XBC + c0) : (v4u){0u, 0u, 0u, 0u}; }
        float dtv[RL / 2];
        if (cc == 0) {
#pragma unroll
            for (int t2 = 0; t2 < RL / 2; ++t2) { const int l = l0 + 2 * t2 + dp; dtv[t2] = l < L ? DT[(size_t)row_of(s, l) * 32 + dl] : 0.f; }
        }
        float acc[RL][8];
#pragma unroll
        for (int t = 0; t < RL; ++t)
#pragma unroll
            for (int i = 0; i < 8; ++i) acc[t][i] = bias[i];
#pragma unroll
        for (int j = 0; j < NROW; ++j) {
            float x[8]; unpack8(rw[j], x);
#pragma unroll
            for (int jj = 0; jj < 5; ++jj) { const int t = j - jj; if (t < 0 || t >= RL) continue;
#pragma unroll
                for (int i = 0; i < 8; ++i) acc[t][i] += wgt[jj][i] * x[i]; }
            const int td = j - 4;
            if (td >= 0) { const int l = l0 + td;
                if (l < L) { v4u o; o.x = pk2(siluf(acc[td][0]), siluf(acc[td][1])); o.y = pk2(siluf(acc[td][2]), siluf(acc[td][3])); o.z = pk2(siluf(acc[td][4]), siluf(acc[td][5])); o.w = pk2(siluf(acc[td][6]), siluf(acc[td][7]));
                    *(v4u*)(XBC + (size_t)row_of(s, l) * 1536 + c0) = o; } }
        }
        if (cc == 0) {
#pragma unroll
            for (int t2 = 0; t2 < RL / 2; ++t2) { const int l = l0 + 2 * t2 + dp;
                if (l < L) { const int row = row_of(s, l); const float x = dtv[t2] + dtb; const float sp = x > 20.f ? x : log1pf(__expf(x));
                    DTL[(size_t)row * 64 + dl] = sp; DTL[(size_t)row * 64 + 32 + dl] = -sp * aexp; } }
        }
    }
}

typedef short s16x4 __attribute__((ext_vector_type(4)));
typedef short v4i16_t __attribute__((ext_vector_type(4)));
constexpr int NCHUNK = 202;
__device__ __forceinline__ void chunk_decode(int cid, int& s, int& c) { if (cid < 66) { s = cid / 33; c = cid - s * 33; } else { const int q = cid - 66; const int s2 = q / 17; s = 2 + s2; c = q - s2 * 17; } }
__device__ __forceinline__ int chunk_row(int s, int c, int t) { return c == 0 ? (t < 112 ? -1 : META0 + s * NMETA + t - 112) : seq_start(s) + (c - 1) * 128 + t; }
__device__ __forceinline__ s16x4 lds_tr(const LAS unsigned char* p) { return __builtin_bit_cast(s16x4, __builtin_amdgcn_ds_read_tr16_b64_v4i16((LAS v4i16_t*)p)); }
__device__ __forceinline__ bf16x8 cat4(s16x4 a, s16x4 b) { return (bf16x8){a[0], a[1], a[2], a[3], b[0], b[1], b[2], b[3]}; }
__device__ __forceinline__ f32x4 mfma16(bf16x8 a, bf16x8 b, f32x4 c) { return __builtin_amdgcn_mfma_f32_16x16x32_bf16(a, b, c, 0, 0, 0); }
__device__ __forceinline__ bf16x8 pack8(const float (&f)[8]) { v4u w; w.x = pk2(f[0], f[1]); w.y = pk2(f[2], f[3]); w.z = pk2(f[4], f[5]); w.w = pk2(f[6], f[7]); return __builtin_bit_cast(bf16x8, w); }

constexpr int XPITCH = 144;
constexpr int SA_BIMG = 0, SA_XP = 73728, SA_DEC = 110592;
constexpr int SC_CIMG = 0, SC_BIMG = 36864, SC_XP = 73728, SC_DEC = 110592, SC_XCH = 126976;
static_assert(SC_XCH + 4096 <= RING_BYTES, "scan LDS map");

constexpr int NHS = 24;

__device__ __forceinline__ float wave_incl_scan(float v, int lane) {
#pragma unroll
    for (int o = 1; o < 64; o <<= 1) { const float u = __shfl_up(v, o); if (lane >= o) v += u; }
    return v;
}
constexpr float LOG2E_G = 1.4426950408889634f;
__device__ __forceinline__ void decay_setup(LAS float* dec, float laf0, float laf1, float lab0, float lab1, float dtf0, float dtf1, float dtb0, float dtb1, int lane, float& cfe, float& cbe) {
    laf0 *= LOG2E_G; laf1 *= LOG2E_G; lab0 *= LOG2E_G; lab1 *= LOG2E_G;
    float f0 = wave_incl_scan(laf0, lane), f1 = wave_incl_scan(laf1, lane);
    const float ft = __shfl(f0, 63); f1 += ft;
    float b0 = wave_incl_scan(lab0, lane), b1 = wave_incl_scan(lab1, lane);
    const float bt = __shfl(b0, 63); b1 += bt;
    cfe = __shfl(f1, 63); cbe = __shfl(b1, 63);
    dec[lane] = f0; dec[64 + lane] = f1;
    dec[128 + lane] = b0 - lab0; dec[192 + lane] = b1 - lab1;
    dec[256 + lane] = __log2f(dtf0) - f0; dec[320 + lane] = __log2f(dtf1) - f1;
    dec[384 + lane] = (b0 - lab0) + __log2f(dtb0); dec[448 + lane] = (b1 - lab1) + __log2f(dtb1);
    LDS_WAIT();
}
struct DecRaw { float laf0, laf1, lab0, lab1, dtf0, dtf1, dtb0, dtb1; };
template <bool SSD>
__device__ __forceinline__ DecRaw decay_raw(const Frame& F, KArgs& a, int layer, int s, int c, int h, int lane) {
    const int r0 = chunk_row(s, c, lane), r1 = chunk_row(s, c, 64 + lane);
    DecRaw d{0.f, 0.f, 0.f, 0.f, 0.f, 0.f, 0.f, 0.f};
    if (SSD) {
        const float* DTL = (const float*)(F.ws + WS_DTL);
        if (r0 >= 0) { const float* p = DTL + (size_t)r0 * 64; d.dtf0 = p[h]; d.dtb0 = p[16 + h]; d.laf0 = p[32 + h]; d.lab0 = p[48 + h]; }
        if (r1 >= 0) { const float* p = DTL + (size_t)r1 * 64; d.dtf1 = p[h]; d.dtb1 = p[16 + h]; d.laf1 = p[32 + h]; d.lab1 = p[48 + h]; }
    } else {
        const float x0 = a.in[13][layer * 16 + h], x1 = a.in[13][layer * 16 + 8 + h];
        const float lgf = fminf(x0, 0.f) - log1pf(__expf(-fabsf(x0))), lgb = fminf(x1, 0.f) - log1pf(__expf(-fabsf(x1)));
        if (r0 >= 0) { d.laf0 = lgf; d.lab0 = lgb; d.dtf0 = 0.125f; d.dtb0 = 0.125f; }
        if (r1 >= 0) { d.laf1 = lgf; d.lab1 = lgb; d.dtf1 = 0.125f; d.dtb1 = 0.125f; }
    }
    return d;
}
template <bool SSD>
__device__ __forceinline__ void decay_load(const Frame& F, KArgs& a, int layer, int s, int c, int h, int lane, LAS float* dec, float& cfe, float& cbe) {
    const DecRaw d = decay_raw<SSD>(F, a, layer, s, c, h, lane);
    decay_setup(dec, d.laf0, d.laf1, d.lab0, d.lab1, d.dtf0, d.dtf1, d.dtb0, d.dtb1, lane, cfe, cbe);
}
template <int NROWS, int PPR>
__device__ __forceinline__ void stage_rows_ld(v4u (&v)[NROWS * PPR / NTHREADS], const bf16* src, int ld, int col0, int s, int c, int t0, int tid) {
    static_assert((NROWS * PPR) % NTHREADS == 0, "stage_rows");
#pragma unroll
    for (int q = 0; q < NROWS * PPR / NTHREADS; ++q) { const int idx = tid + q * NTHREADS, r = idx / PPR, pc = idx % PPR; const int row = chunk_row(s, c, t0 + r);
        v[q] = row >= 0 ? *(const v4u*)(src + (size_t)row * ld + col0 + pc * 8) : (v4u){0u, 0u, 0u, 0u}; }
}
template <int NROWS, int PPR>
__device__ __forceinline__ void stage_rows_st(const v4u (&v)[NROWS * PPR / NTHREADS], LAS unsigned char* dst, int pitchB, int tid) {
#pragma unroll
    for (int q = 0; q < NROWS * PPR / NTHREADS; ++q) { const int idx = tid + q * NTHREADS, r = idx / PPR, pc = idx % PPR; *(LAS v4u*)(dst + r * pitchB + pc * 16) = v[q]; }
}
template <int NROWS, int PPR>
__device__ __forceinline__ void stage_rows(LAS unsigned char* dst, int pitchB, const bf16* src, int ld, int col0, int s, int c, int t0, int tid) {
    v4u v[NROWS * PPR / NTHREADS]; stage_rows_ld<NROWS, PPR>(v, src, ld, col0, s, c, t0, tid); stage_rows_st<NROWS, PPR>(v, dst, pitchB, tid);
}
__device__ __forceinline__ void xblock_load(v4u (&xr)[4], const bf16* src, int ld, int col0, int s, int c, int sb, int lane) {
#pragma unroll
    for (int q = 0; q < 4; ++q) { const int idx = lane + 64 * q, r = idx >> 3, pc = idx & 7; const int row = chunk_row(s, c, sb * 32 + r);
        xr[q] = row >= 0 ? *(const v4u*)(src + (size_t)row * ld + col0 + pc * 8) : (v4u){0u, 0u, 0u, 0u}; }
}
__device__ __forceinline__ void xblock_store(const v4u (&xr)[4], LAS unsigned char* xp, int lane) {
#pragma unroll
    for (int q = 0; q < 4; ++q) { const int idx = lane + 64 * q, r = idx >> 3, pc = idx & 7; *(LAS v4u*)(xp + r * XPITCH + pc * 16) = xr[q]; }
}

template <int NK>
__device__ __forceinline__ void scanA_job(const LAS unsigned char* bimg, LAS unsigned char* xp, const LAS float* dec, float cfe,
                                          const bf16* xsrc, int xld, int xcol0, int s, int c, bf16* locf, bf16* locb, int lane, const v4u (&xr0)[4]) {
    constexpr int NKP2 = (NK + 8) * 2, NPASS = NK / 64;
    const int g = lane >> 4, i = lane & 15;
#pragma unroll 1
    for (int np = 0; np < NPASS; ++np) {
        f32x4 Lf[4][4], Lb[4][4];
#pragma unroll
        for (int pt = 0; pt < 4; ++pt)
#pragma unroll
            for (int nt = 0; nt < 4; ++nt) { Lf[pt][nt] = (f32x4){0.f, 0.f, 0.f, 0.f}; Lb[pt][nt] = (f32x4){0.f, 0.f, 0.f, 0.f}; }
        v4u xr[4];
        if (np == 0) {
#pragma unroll
            for (int q = 0; q < 4; ++q) xr[q] = xr0[q]; } else xblock_load(xr, xsrc, xld, xcol0, s, c, 0, lane);
#pragma unroll 1
        for (int sb = 0; sb < 4; ++sb) {
            xblock_store(xr, xp, lane);
            if (sb < 3) xblock_load(xr, xsrc, xld, xcol0, s, c, sb + 1, lane);
            float wf[8], wb[8];
            { const LAS float* d = dec + sb * 32 + 8 * g;
              const f32x4 a0 = *(const LAS f32x4*)(d + 256), a1 = *(const LAS f32x4*)(d + 260), b0 = *(const LAS f32x4*)(d + 384), b1 = *(const LAS f32x4*)(d + 388);
#pragma unroll
              for (int j = 0; j < 4; ++j) { wf[j] = __builtin_amdgcn_exp2f(cfe + a0[j]); wf[4 + j] = __builtin_amdgcn_exp2f(cfe + a1[j]); wb[j] = __builtin_amdgcn_exp2f(b0[j]); wb[4 + j] = __builtin_amdgcn_exp2f(b1[j]); } }
            LDS_WAIT();
            bf16x8 xaf[4], xab[4];
#pragma unroll
            for (int pt = 0; pt < 4; ++pt) {
                const LAS unsigned char* ap = xp + (8 * g + (i >> 2)) * XPITCH + (16 * pt + 4 * (i & 3)) * 2;
                const bf16x8 raw = cat4(lds_tr(ap), lds_tr(ap + 4 * XPITCH));
                float x[8]; unpack8(__builtin_bit_cast(v4u, raw), x);
                float xf[8], xb[8];
#pragma unroll
                for (int j = 0; j < 8; ++j) { xf[j] = x[j] * wf[j]; xb[j] = x[j] * wb[j]; }
                xaf[pt] = pack8(xf); xab[pt] = pack8(xb);
            }
#pragma unroll
            for (int nt = 0; nt < 4; ++nt) {
                const LAS unsigned char* bp = bimg + (sb * 32 + 8 * g + (i >> 2)) * NKP2 + (np * 64 + 16 * nt + 4 * (i & 3)) * 2;
                const bf16x8 bb = cat4(lds_tr(bp), lds_tr(bp + 4 * NKP2));
#pragma unroll
                for (int pt = 0; pt < 4; ++pt) { Lf[pt][nt] = mfma16(xaf[pt], bb, Lf[pt][nt]); Lb[pt][nt] = mfma16(xab[pt], bb, Lb[pt][nt]); }
            }
        }
        { int lz = lane; asm volatile("" : "+v"(lz));
          const int ob = (4 * (lz >> 4)) * NK + np * 64 + (lz & 15);
#pragma unroll
          for (int pt = 0; pt < 4; ++pt)
#pragma unroll
            for (int nt = 0; nt < 4; ++nt)
#pragma unroll
                for (int r = 0; r < 4; ++r) { const int o = ob + (16 * pt + r) * NK + 16 * nt; locf[o] = (bf16)f2bf(Lf[pt][nt][r]); locb[o] = (bf16)f2bf(Lb[pt][nt][r]); } }
    }
}

__device__ __forceinline__ void p_scanA(const Frame& F, KArgs& a, int layer) {
    const bf16* P = (const bf16*)(F.ws + WS_P);
    const bf16* XBC = (const bf16*)(F.ws + WS_XBC);
    bf16* LOC = (bf16*)(F.ws + WS_LOC);
    float* CDEC = (float*)(F.ws + WS_CDEC);
    LAS unsigned char* xp = F.lds + SA_XP + F.wave * 4608;
    LAS float* dec = (LAS float*)(F.lds + SA_DEC + F.wave * 2048);
    const int NBG = bg_entries(1, layer);
    DYN_LOOP_BEGIN(q, 808 + NBG, layer * 4 + 1)
        int u; const int be = bg_split(q, 808, NBG, u);
        if (be >= 0) { bg_entry(F, a, 1, layer, be); } else {
        const bool ssd = u < 404; const int uu = ssd ? u : u - 404; const int cid = uu >> 1, sub = uu & 1;
        int s, c; chunk_decode(cid, s, c);
        __syncthreads();
        float cfe, cbe;
        int tz = F.tid; asm volatile("" : "+v"(tz));
        if (ssd) {
            const int h = sub * 8 + F.wave;
            v4u sb_[4]; stage_rows_ld<128, 16>(sb_, XBC, 1536, 1024 + sub * 128, s, c, 0, tz);
            const DecRaw dr = decay_raw<true>(F, a, layer, s, c, h, tz & 63);
            v4u xr0[4]; xblock_load(xr0, XBC, 1536, h * 64, s, c, 0, tz & 63);
            stage_rows_st<128, 16>(sb_, F.lds + SA_BIMG, 272, tz);
            decay_setup(dec, dr.laf0, dr.laf1, dr.lab0, dr.lab1, dr.dtf0, dr.dtf1, dr.dtb0, dr.dtb1, tz & 63, cfe, cbe);
            __syncthreads();
            bf16* lf = LOC + ((size_t)(cid * NHS + h) * 2) * 8192;
            int lz = F.lane; asm volatile("" : "+v"(lz));
            scanA_job<128>(F.lds + SA_BIMG, xp, dec, cfe, XBC, 1536, h * 64, s, c, lf, lf + 8192, lz, xr0);
            if (F.lane == 0) { CDEC[(cid * NHS + h) * 2] = __builtin_amdgcn_exp2f(cfe); CDEC[(cid * NHS + h) * 2 + 1] = __builtin_amdgcn_exp2f(cbe); }
        } else {
            const int hd = F.wave >> 1, vh = F.wave & 1, h = sub * 4 + hd;
            v4u sk_[4][2];
#pragma unroll
            for (int k = 0; k < 4; ++k) stage_rows_ld<128, 8>(sk_[k], P, P_LD, PC_RET + 512 + (sub * 4 + k) * 64, s, c, 0, tz);
            const DecRaw dr = decay_raw<false>(F, a, layer, s, c, h, tz & 63);
            v4u xr0[4]; xblock_load(xr0, P, P_LD, PC_RET + 1024 + h * 128 + vh * 64, s, c, 0, tz & 63);
#pragma unroll
            for (int k = 0; k < 4; ++k) stage_rows_st<128, 8>(sk_[k], F.lds + SA_BIMG + k * 18432, 144, tz);
            decay_setup(dec, dr.laf0, dr.laf1, dr.lab0, dr.lab1, dr.dtf0, dr.dtf1, dr.dtb0, dr.dtb1, tz & 63, cfe, cbe);
            __syncthreads();
            bf16* lf = LOC + ((size_t)(cid * NHS + 16 + h) * 2) * 8192 + vh * 64 * 64;
            int lz = F.lane; asm volatile("" : "+v"(lz));
            scanA_job<64>(F.lds + SA_BIMG + hd * 18432, xp, dec, cfe, P, P_LD, PC_RET + 1024 + h * 128 + vh * 64, s, c, lf, lf + 8192, lz, xr0);
            if (F.lane == 0 && vh == 0) { CDEC[(cid * NHS + 16 + h) * 2] = __builtin_amdgcn_exp2f(cfe); CDEC[(cid * NHS + 16 + h) * 2 + 1] = __builtin_amdgcn_exp2f(cbe); }
        }
        }
    DYN_LOOP_END(q)
    __syncthreads();
}

__device__ __forceinline__ void p_scanB(const Frame& F, KArgs& a) {
    const bf16* LOC = (const bf16*)(F.ws + WS_LOC);
    const float* CDEC = (const float*)(F.ws + WS_CDEC);
    bf16* SIN = (bf16*)(F.ws + WS_SIN);
    for (int it = blockIdx.x; it < 960; it += F.G) {
        const int sl = it & 1, dir = (it >> 1) & 1, hs = (it >> 2) % NHS, s = (it >> 2) / NHS;
        const int nch = s < 2 ? 33 : 17, cb = s < 2 ? s * 33 : 66 + (s - 2) * 17;
        const int e = sl * 4096 + F.tid * 8;
        v4u lv[33]; float dv[33];
#pragma unroll
        for (int k = 0; k < 33; ++k) { const int kk = k < nch ? k : nch - 1; const int c = dir == 0 ? kk : nch - 1 - kk; const size_t o = ((size_t)((cb + c) * NHS + hs) * 2 + dir) * 8192 + e;
            lv[k] = *(const v4u*)(LOC + o); dv[k] = CDEC[((cb + c) * NHS + hs) * 2 + dir]; }
        float run[8];
#pragma unroll
        for (int j = 0; j < 8; ++j) run[j] = 0.f;
#pragma unroll
        for (int k = 0; k < 33; ++k) {
            if (k < nch) { const int c = dir == 0 ? k : nch - 1 - k; const size_t o = ((size_t)((cb + c) * NHS + hs) * 2 + dir) * 8192 + e;
                v4u w; w.x = pk2(run[0], run[1]); w.y = pk2(run[2], run[3]); w.z = pk2(run[4], run[5]); w.w = pk2(run[6], run[7]);
                *(v4u*)(SIN + o) = w;
                float l[8]; unpack8(lv[k], l);
#pragma unroll
                for (int j = 0; j < 8; ++j) run[j] = run[j] * dv[k] + l[j]; }
        }
    }
}

template <int NK>
__device__ __forceinline__ void scanC_job(f32x4 (&y)[4][4], const LAS unsigned char* cimg, const LAS unsigned char* bimg, LAS unsigned char* xp, const LAS float* dec, float cbe,
                                          const bf16* xsrc, int xld, int xcol0, int s, int c, int lbase, float dskip, const bf16* sinf, const bf16* sinb, int lane, const v4u (&xr0)[4]) {
    constexpr int NKP2 = (NK + 8) * 2, KS = NK / 32;
    const int g = lane >> 4, i = lane & 15;
#pragma unroll
    for (int lt = 0; lt < 4; ++lt)
#pragma unroll
        for (int pt = 0; pt < 4; ++pt) y[lt][pt] = (f32x4){0.f, 0.f, 0.f, 0.f};
    v4u xr[4];
#pragma unroll
    for (int q = 0; q < 4; ++q) xr[q] = xr0[q];
#pragma unroll 1
    for (int sb = 0; sb < 4; ++sb) {
        xblock_store(xr, xp, lane);
        if (sb < 3) xblock_load(xr, xsrc, xld, xcol0, s, c, sb + 1, lane);
        const LAS float* d = dec + sb * 32 + 4 * g;
        const f32x4 A0 = *(const LAS f32x4*)(d + 256), A1 = *(const LAS f32x4*)(d + 272), B0 = *(const LAS f32x4*)(d + 384), B1 = *(const LAS f32x4*)(d + 400);
        LDS_WAIT();
        bf16x8 xf[4];
#pragma unroll
        for (int pt = 0; pt < 4; ++pt) { const LAS unsigned char* ap = xp + (4 * g + (i >> 2)) * XPITCH + (16 * pt + 4 * (i & 3)) * 2; xf[pt] = cat4(lds_tr(ap), lds_tr(ap + 16 * XPITCH)); }
#pragma unroll
        for (int lt = 0; lt < 4; ++lt) {
            const int l = lbase + 16 * lt + i;
            const float cfl = dec[l], ebl = dec[128 + l];
            f32x4 t0 = (f32x4){0.f, 0.f, 0.f, 0.f}, t1 = (f32x4){0.f, 0.f, 0.f, 0.f};
#pragma unroll
            for (int kk = 0; kk < KS; ++kk) { const bf16x8 cf = *(const LAS bf16x8*)(cimg + (16 * lt + i) * NKP2 + (kk * 32 + 8 * g) * 2);
                const bf16x8 b0 = *(const LAS bf16x8*)(bimg + (sb * 32 + i) * NKP2 + (kk * 32 + 8 * g) * 2), b1 = *(const LAS bf16x8*)(bimg + (sb * 32 + 16 + i) * NKP2 + (kk * 32 + 8 * g) * 2);
                t0 = mfma16(b0, cf, t0); t1 = mfma16(b1, cf, t1); }
            float m[8];
            const int lt_lo = lbase + 16 * lt;
            if (sb * 32 + 31 < lt_lo) {
#pragma unroll
                for (int r = 0; r < 4; ++r) { m[r] = t0[r] * __builtin_amdgcn_exp2f(cfl + A0[r]); m[4 + r] = t1[r] * __builtin_amdgcn_exp2f(cfl + A1[r]); }
            } else if (sb * 32 > lt_lo + 15) {
#pragma unroll
                for (int r = 0; r < 4; ++r) { m[r] = t0[r] * __builtin_amdgcn_exp2f(B0[r] - ebl); m[4 + r] = t1[r] * __builtin_amdgcn_exp2f(B1[r] - ebl); }
            } else {
#pragma unroll
                for (int r = 0; r < 4; ++r) {
                    const int s0 = sb * 32 + 4 * g + r, s1 = s0 + 16;
                    m[r] = t0[r] * __builtin_amdgcn_exp2f(s0 <= l ? cfl + A0[r] : B0[r] - ebl) + (s0 == l ? dskip : 0.f);
                    m[4 + r] = t1[r] * __builtin_amdgcn_exp2f(s1 <= l ? cfl + A1[r] : B1[r] - ebl) + (s1 == l ? dskip : 0.f);
                }
            }
            const bf16x8 af = pack8(m);
#pragma unroll
            for (int pt = 0; pt < 4; ++pt) y[lt][pt] = mfma16(xf[pt], af, y[lt][pt]);
            __builtin_amdgcn_sched_barrier(0);
        }
    }
#pragma unroll 1
    for (int dir = 0; dir < 2; ++dir) {
        const bf16* S = dir == 0 ? sinf : sinb;
        bf16x8 sf[4][KS];
#pragma unroll
        for (int pt = 0; pt < 4; ++pt)
#pragma unroll
            for (int kk = 0; kk < KS; ++kk) sf[pt][kk] = *(const bf16x8*)(S + (size_t)(16 * pt + i) * NK + kk * 32 + 8 * g);
        float sc[4];
#pragma unroll
        for (int lt = 0; lt < 4; ++lt) { const int l = lbase + 16 * lt + i; sc[lt] = dir == 0 ? __builtin_amdgcn_exp2f(dec[l]) : __builtin_amdgcn_exp2f(cbe - dec[128 + l]); }
#pragma unroll
        for (int lt = 0; lt < 4; ++lt) {
            bf16x8 cf[KS];
#pragma unroll
            for (int kk = 0; kk < KS; ++kk) cf[kk] = *(const LAS bf16x8*)(cimg + (16 * lt + i) * NKP2 + (kk * 32 + 8 * g) * 2);
#pragma unroll
            for (int pt = 0; pt < 4; ++pt) {
                f32x4 t = (f32x4){0.f, 0.f, 0.f, 0.f};
#pragma unroll
                for (int kk = 0; kk < KS; ++kk) t = mfma16(sf[pt][kk], cf[kk], t);
                y[lt][pt] = y[lt][pt] + t * sc[lt];
            }
        }
    }
}

__device__ __forceinline__ void p_scanC(const Frame& F, KArgs& a, int layer) {
    const bf16* P = (const bf16*)(F.ws + WS_P);
    const bf16* XBC = (const bf16*)(F.ws + WS_XBC);
    const bf16* SIN = (const bf16*)(F.ws + WS_SIN);
    bf16* XN = (bf16*)(F.ws + WS_XN);
    LAS unsigned char* xp = F.lds + SC_XP + F.wave * 4608;
    LAS float* dec = (LAS float*)(F.lds + SC_DEC + F.wave * 2048);
    LAS float* xch = (LAS float*)(F.lds + SC_XCH);
    const int NBG = bg_entries(2, layer);
    DYN_LOOP_BEGIN(q, 1616 + NBG, layer * 4 + 2)
        int u; const int be = bg_split(q, 1616, NBG, u);
        if (be >= 0) { bg_entry(F, a, 2, layer, be); } else {
        const bool ssd = u < 808; const int uu = ssd ? u : u - 808; const int cid = uu >> 2, sub = uu & 3;
        int s, c; chunk_decode(cid, s, c);
        __syncthreads();
        float cfe, cbe; f32x4 y[4][4];
        int tz = F.tid; asm volatile("" : "+v"(tz));
        if (ssd) {
            const int grp = sub >> 1, lh = sub & 1, h = grp * 8 + F.wave;
            v4u sc_[2], sb_[4]; stage_rows_ld<64, 16>(sc_, XBC, 1536, 1280 + grp * 128, s, c, lh * 64, tz); stage_rows_ld<128, 16>(sb_, XBC, 1536, 1024 + grp * 128, s, c, 0, tz);
            const DecRaw dr = decay_raw<true>(F, a, layer, s, c, h, tz & 63);
            v4u xr0[4]; xblock_load(xr0, XBC, 1536, h * 64, s, c, 0, tz & 63);
            stage_rows_st<64, 16>(sc_, F.lds + SC_CIMG, 272, tz); stage_rows_st<128, 16>(sb_, F.lds + SC_BIMG, 272, tz);
            decay_setup(dec, dr.laf0, dr.laf1, dr.lab0, dr.lab1, dr.dtf0, dr.dtf1, dr.dtb0, dr.dtb1, tz & 63, cfe, cbe);
            __syncthreads();
            const bf16* sf = SIN + ((size_t)(cid * NHS + h) * 2) * 8192;
            int ly = F.lane; asm volatile("" : "+v"(ly));
            scanC_job<128>(y, F.lds + SC_CIMG, F.lds + SC_BIMG, xp, dec, cbe, XBC, 1536, h * 64, s, c, lh * 64, a.in[9][layer * 16 + h], sf, sf + 8192, ly, xr0);
            int lz = F.lane; asm volatile("" : "+v"(lz)); const int g = lz >> 4, i = lz & 15;
            v2u zz[4][4]; int rowl[4];
#pragma unroll
            for (int lt = 0; lt < 4; ++lt) { rowl[lt] = chunk_row(s, c, lh * 64 + 16 * lt + i);
#pragma unroll
                for (int pt = 0; pt < 4; ++pt) zz[lt][pt] = rowl[lt] >= 0 ? *(const v2u*)(P + (size_t)rowl[lt] * P_LD + PC_Z + h * 64 + 16 * pt + 4 * g) : (v2u){0u, 0u}; }
#pragma unroll
            for (int lt = 0; lt < 4; ++lt) { float acc = 0.f;
#pragma unroll
                for (int pt = 0; pt < 4; ++pt) { const f32x4 zf = (f32x4){bflo(zz[lt][pt].x), bfhi(zz[lt][pt].x), bflo(zz[lt][pt].y), bfhi(zz[lt][pt].y)};
#pragma unroll
                    for (int r = 0; r < 4; ++r) { const float v = y[lt][pt][r] * siluf(zf[r]); y[lt][pt][r] = v; acc += v * v; } }
                acc += __shfl_xor(acc, 16); acc += __shfl_xor(acc, 32);
                if (g == 0) xch[F.wave * 64 + 16 * lt + i] = acc; }
            __syncthreads();
            const float* nw = a.in[10] + layer * 1024 + h * 64;
#pragma unroll
            for (int lt = 0; lt < 4; ++lt) { float tot = 0.f;
#pragma unroll
                for (int w = 0; w < 8; ++w) tot += xch[w * 64 + 16 * lt + i];
                const float rstd = rsqrtf(tot * (1.f / 512.f) + EPS);
                if (rowl[lt] >= 0) {
#pragma unroll
                    for (int pt = 0; pt < 4; ++pt) { const f32x4 wv = *(const f32x4*)(nw + 16 * pt + 4 * g); const f32x4 o = y[lt][pt] * rstd * wv;
                        *(v2u*)(XN + (size_t)rowl[lt] * D + h * 64 + 16 * pt + 4 * g) = (v2u){pk2(o[0], o[1]), pk2(o[2], o[3])}; } } }
        } else {
            const int hd = F.wave >> 2, vh = (F.wave >> 1) & 1, lh = F.wave & 1, h = sub * 2 + hd;
            v4u sq_[2][2], sk_[2][2];
#pragma unroll
            for (int k = 0; k < 2; ++k) { stage_rows_ld<128, 8>(sq_[k], P, P_LD, PC_RET + (sub * 2 + k) * 64, s, c, 0, tz); stage_rows_ld<128, 8>(sk_[k], P, P_LD, PC_RET + 512 + (sub * 2 + k) * 64, s, c, 0, tz); }
            const DecRaw dr = decay_raw<false>(F, a, layer, s, c, h, tz & 63);
            v4u xr0[4]; xblock_load(xr0, P, P_LD, PC_RET + 1024 + h * 128 + vh * 64, s, c, 0, tz & 63);
#pragma unroll
            for (int k = 0; k < 2; ++k) { stage_rows_st<128, 8>(sq_[k], F.lds + SC_CIMG + k * 18432, 144, tz); stage_rows_st<128, 8>(sk_[k], F.lds + SC_BIMG + k * 18432, 144, tz); }
            decay_setup(dec, dr.laf0, dr.laf1, dr.lab0, dr.lab1, dr.dtf0, dr.dtf1, dr.dtb0, dr.dtb1, tz & 63, cfe, cbe);
            __syncthreads();
            const bf16* sf = SIN + ((size_t)(cid * NHS + 16 + h) * 2) * 8192 + vh * 64 * 64;
            int ly = F.lane; asm volatile("" : "+v"(ly));
            scanC_job<64>(y, F.lds + SC_CIMG + hd * 18432 + lh * 64 * 144, F.lds + SC_BIMG + hd * 18432, xp, dec, cbe, P, P_LD, PC_RET + 1024 + h * 128 + vh * 64, s, c, lh * 64, 0.f, sf, sf + 8192, ly, xr0);
            int lz = F.lane; asm volatile("" : "+v"(lz)); const int g = lz >> 4, i = lz & 15;
            v2u gz[4][4]; int rowl[4]; float sm[4], sq[4];
#pragma unroll
            for (int lt = 0; lt < 4; ++lt) { rowl[lt] = chunk_row(s, c, lh * 64 + 16 * lt + i);
#pragma unroll
                for (int pt = 0; pt < 4; ++pt) gz[lt][pt] = rowl[lt] >= 0 ? *(const v2u*)(P + (size_t)rowl[lt] * P_LD + PC_RET + 2048 + h * 128 + vh * 64 + 16 * pt + 4 * g) : (v2u){0u, 0u}; }
#pragma unroll
            for (int lt = 0; lt < 4; ++lt) { float a1 = 0.f, a2 = 0.f;
#pragma unroll
                for (int pt = 0; pt < 4; ++pt)
#pragma unroll
                    for (int r = 0; r < 4; ++r) { const float v = y[lt][pt][r]; a1 += v; a2 += v * v; }
                a1 += __shfl_xor(a1, 16); a1 += __shfl_xor(a1, 32); a2 += __shfl_xor(a2, 16); a2 += __shfl_xor(a2, 32); sm[lt] = a1; sq[lt] = a2;
                if (g == 0) { xch[(F.wave * 64 + 16 * lt + i) * 2] = a1; xch[(F.wave * 64 + 16 * lt + i) * 2 + 1] = a2; } }
            __syncthreads();
            const int pw = F.wave ^ 2;
#pragma unroll
            for (int lt = 0; lt < 4; ++lt) {
                const float t1 = sm[lt] + xch[(pw * 64 + 16 * lt + i) * 2], t2 = sq[lt] + xch[(pw * 64 + 16 * lt + i) * 2 + 1];
                const float mu = t1 * (1.f / 128.f), var = fmaxf(t2 * (1.f / 128.f) - mu * mu, 0.f), rstd = rsqrtf(var + 1e-5f);
                if (rowl[lt] >= 0) {
#pragma unroll
                    for (int pt = 0; pt < 4; ++pt) { const f32x4 gf = (f32x4){bflo(gz[lt][pt].x), bfhi(gz[lt][pt].x), bflo(gz[lt][pt].y), bfhi(gz[lt][pt].y)}; f32x4 o;
#pragma unroll
                        for (int r = 0; r < 4; ++r) o[r] = (y[lt][pt][r] - mu) * rstd * siluf(gf[r]);
                        *(v2u*)(XN + (size_t)rowl[lt] * D + 3072 + h * 128 + vh * 64 + 16 * pt + 4 * g) = (v2u){pk2(o[0], o[1]), pk2(o[2], o[3])}; } } }
        }
        }
    DYN_LOOP_END(q)
    __syncthreads();
}

constexpr int SW_KB = 0, SW_VB = 34816, SW_BLK = 17408;
__device__ __forceinline__ void swa_blk_load(v4u (&kv)[4], const bf16* P, int s, int kb, int nkb, int grp, int tid) {
#pragma unroll
    for (int q = 0; q < 4; ++q) { const int idx = tid + q * NTHREADS, isv = idx >> 10, r = (idx >> 4) & 63, pc = idx & 15;
        int row; if (kb >= 0) row = seq_start(s) + kb * 64 + r; else row = r < NMETA ? META0 + s * NMETA + r : -1;
        kv[q] = row >= 0 ? *(const v4u*)(P + (size_t)row * P_LD + PC_SWA + 1024 + isv * 256 + grp * 128 + pc * 8) : (v4u){0u, 0u, 0u, 0u}; }
}
__device__ __forceinline__ void swa_blk_store(const v4u (&kv)[4], LAS unsigned char* lds, int buf, int tid) {
#pragma unroll
    for (int q = 0; q < 4; ++q) { const int idx = tid + q * NTHREADS, isv = idx >> 10, r = (idx >> 4) & 63, pc = idx & 15;
        *(LAS v4u*)(lds + (isv ? SW_VB : SW_KB) + buf * SW_BLK + r * 272 + pc * 16) = kv[q]; }
}
__device__ __forceinline__ void swa_unit(const Frame& F, KArgs& a, int layer, int u) {
    const bf16* P = (const bf16*)(F.ws + WS_P);
    bf16* XN = (bf16*)(F.ws + WS_XN);
    constexpr float LOG2E = 1.4426950408889634f;
    {
        int s, qb, grp;
        if (u < 768) { const int ub = u >> 1; grp = u & 1; if (ub < 128) { s = ub >> 6; qb = ub & 63; } else { s = 2 + ((ub - 128) >> 5); qb = (ub - 128) & 31; } }
        else { s = (u - 768) >> 1; grp = u & 1; qb = -1; }
        const int T = seq_T(s), st0 = seq_start(s);
        const int kb_lo = qb < 0 ? 0 : (qb - 2 < 0 ? 0 : qb - 2), kb_hi = qb < 0 ? 1 : (qb + 2 > T / 64 - 1 ? T / 64 - 1 : qb + 2);
        const int nblk = kb_hi - kb_lo + 2;
        int tz = F.tid; asm volatile("" : "+v"(tz));
        const int lane = tz & 63, g = lane >> 4, i = lane & 15;
        const int hr = F.wave >> 1, half = F.wave & 1, hq = grp * 4 + hr;
        const int nq = qb < 0 ? NMETA : 64;
        bf16x8 qf[2][4]; int posq[2];
#pragma unroll
        for (int qt = 0; qt < 2; ++qt) { const int qi = half * 32 + 16 * qt + i; const bool ok = qi < nq; const int qc = ok ? qi : 0;
            const int row = qb < 0 ? META0 + s * NMETA + qc : st0 + qb * 64 + qc; posq[qt] = qb < 0 ? qc : NMETA + qb * 64 + qc;
#pragma unroll
            for (int kk = 0; kk < 4; ++kk) qf[qt][kk] = *(const bf16x8*)(P + (size_t)row * P_LD + PC_SWA + hq * 128 + kk * 32 + 8 * g); }
        const float slope2 = exp2f(-(float)(hq + 1)) * LOG2E, scale2 = 0.08838834764831845f * LOG2E;
        f32x4 O[2][8]; float lp[2] = {0.f, 0.f};
#pragma unroll
        for (int qt = 0; qt < 2; ++qt)
#pragma unroll
            for (int dt = 0; dt < 8; ++dt) O[qt][dt] = (f32x4){0.f, 0.f, 0.f, 0.f};
        v4u kv[4];
        swa_blk_load(kv, P, s, kb_lo, 0, grp, tz);
        __syncthreads();
#pragma unroll 1
        for (int b = 0; b < nblk; ++b) {
            const int buf = b & 1;
            swa_blk_store(kv, F.lds, buf, tz);
            if (b + 1 < nblk) swa_blk_load(kv, P, s, (b + 1 < nblk - 1) ? kb_lo + b + 1 : -1, 0, grp, tz);
            __syncthreads();
            const bool ismeta = (b == nblk - 1);
            const int kpos0 = ismeta ? 0 : NMETA + (kb_lo + b) * 64;
            const LAS unsigned char* kb_ = F.lds + SW_KB + buf * SW_BLK;
            const LAS unsigned char* vb_ = F.lds + SW_VB + buf * SW_BLK;
#pragma unroll
            for (int h2 = 0; h2 < 2; ++h2) {
                if (ismeta && h2 == 1) continue;
                bf16x8 kf0[4], kf1[4];
#pragma unroll
                for (int kk = 0; kk < 4; ++kk) { kf0[kk] = *(const LAS bf16x8*)(kb_ + (h2 * 32 + i) * 272 + (kk * 32 + 8 * g) * 2); kf1[kk] = *(const LAS bf16x8*)(kb_ + (h2 * 32 + 16 + i) * 272 + (kk * 32 + 8 * g) * 2); }
                bf16x8 vf[8];
#pragma unroll
                for (int dt = 0; dt < 8; ++dt) { const LAS unsigned char* ap = vb_ + (h2 * 32 + 4 * g + (i >> 2)) * 272 + (16 * dt + 4 * (i & 3)) * 2; vf[dt] = cat4(lds_tr(ap), lds_tr(ap + 16 * 272)); }
#pragma unroll
                for (int qt = 0; qt < 2; ++qt) {
                    f32x4 t0 = (f32x4){0.f, 0.f, 0.f, 0.f}, t1 = (f32x4){0.f, 0.f, 0.f, 0.f};
#pragma unroll
                    for (int kk = 0; kk < 4; ++kk) { t0 = mfma16(kf0[kk], qf[qt][kk], t0); t1 = mfma16(kf1[kk], qf[qt][kk], t1); }
                    float m[8]; float ls = 0.f;
                    const float dfl = (float)(kpos0 + h2 * 32 + 4 * g - posq[qt]);
                    const bool edge = (qb < 0 || kb_lo + b <= qb - 2 || kb_lo + b >= qb + 2);
                    if (ismeta) {
#pragma unroll
                        for (int r = 0; r < 4; ++r) { const float p0 = (h2 * 32 + 4 * g + r < NMETA) ? __builtin_amdgcn_exp2f(fminf(t0[r] * scale2, 86.f)) : 0.f; m[r] = p0; m[4 + r] = 0.f; ls += p0; }
                    } else {
#pragma unroll
                        for (int r = 0; r < 4; ++r) { const float x0 = dfl + (float)r, x1 = dfl + (float)(r + 16);
                            float p0 = __builtin_amdgcn_exp2f(fminf(t0[r] * scale2 - slope2 * fabsf(x0), 86.f)), p1 = __builtin_amdgcn_exp2f(fminf(t1[r] * scale2 - slope2 * fabsf(x1), 86.f));
                            if (edge) { p0 = fabsf(x0) <= 128.f ? p0 : 0.f; p1 = fabsf(x1) <= 128.f ? p1 : 0.f; }
                            m[r] = p0; m[4 + r] = p1; ls += p0 + p1; }
                    }
                    lp[qt] += ls;
                    const bf16x8 af = pack8(m);
#pragma unroll
                    for (int dt = 0; dt < 8; ++dt) O[qt][dt] = mfma16(vf[dt], af, O[qt][dt]);
                }
                __builtin_amdgcn_sched_barrier(0);
            }
        }
        const float snk = exp2f(a.in[11][layer * 8 + hq] * LOG2E);
        int lz = F.lane; asm volatile("" : "+v"(lz)); const int g2 = lz >> 4, i2 = lz & 15;
#pragma unroll
        for (int qt = 0; qt < 2; ++qt) {
            float l = lp[qt]; l += __shfl_xor(l, 16); l += __shfl_xor(l, 32); l += snk;
            const float inv = __builtin_amdgcn_rcpf(l);
            const int qi = half * 32 + 16 * qt + i2;
            if (qi < nq) { const int row = qb < 0 ? META0 + s * NMETA + qi : st0 + qb * 64 + qi;
#pragma unroll
                for (int dt = 0; dt < 8; ++dt) { const f32x4 o = O[qt][dt] * inv; *(v2u*)(XN + (size_t)row * D + 1024 + hq * 128 + 16 * dt + 4 * g2) = (v2u){pk2(o[0], o[1]), pk2(o[2], o[3])}; } }
        }
    }
}
constexpr int NA_STG = 36864, NA_V = 18432, NA_RPB = 73728;
__device__ __forceinline__ void na_row_load(v4u (&kv)[4], const bf16* P, int s, int kr, int hp, int tid) {
#pragma unroll
    for (int q = 0; q < 4; ++q) { const int idx = tid + q * NTHREADS, isv = idx >> 10, hd = (idx >> 9) & 1, tok = (idx >> 3) & 63, pc = idx & 7;
        int row; if (kr >= 0) row = seq_start(s) + kr * 64 + tok; else row = tok < NMETA ? META0 + s * NMETA + tok : -1;
        kv[q] = row >= 0 ? *(const v4u*)(P + (size_t)row * P_LD + PC_NA + 1024 * (1 + isv) + (hp * 2 + hd) * 64 + pc * 8) : (v4u){0u, 0u, 0u, 0u}; }
}
__device__ __forceinline__ void na_row_store(const v4u (&kv)[4], LAS unsigned char* lds, int buf, int tid) {
#pragma unroll
    for (int q = 0; q < 4; ++q) { const int idx = tid + q * NTHREADS, isv = idx >> 10, hd = (idx >> 9) & 1, tok = (idx >> 3) & 63, pc = idx & 7;
        *(LAS v4u*)(lds + buf * NA_STG + isv * NA_V + hd * 9216 + tok * 144 + pc * 16) = kv[q]; }
}
__device__ __forceinline__ void na_unit(const Frame& F, KArgs& a, int layer, int u) {
    const bf16* P = (const bf16*)(F.ws + WS_P);
    bf16* XN = (bf16*)(F.ws + WS_XN);
    constexpr float LOG2E = 1.4426950408889634f;
    LAS float* rpbl = (LAS float*)(F.lds + NA_RPB);
    {
        int s, R, hp;
        if (u < 768) { hp = u & 7; const int q4 = u >> 3; if (q4 < 32) { s = q4 >> 4; R = (q4 & 15) * 4; } else { s = 2 + ((q4 - 32) >> 3); R = ((q4 - 32) & 7) * 4; } }
        else { hp = (u - 768) & 7; s = (u - 768) >> 3; R = -1; }
        const int T = seq_T(s), st0 = seq_start(s), nrows = T >> 6;
        int tz = F.tid; asm volatile("" : "+v"(tz));
        const int lane = tz & 63, g = lane >> 4, i = lane & 15;
        const int hd = F.wave >> 2, ct = F.wave & 3, h = hp * 2 + hd;
        int kr_lo, kr_hi;
        if (R >= 0) { int a0 = R - 4; a0 = a0 < 0 ? 0 : (a0 > nrows - 8 ? nrows - 8 : a0); int a1 = R + 3 - 4; a1 = a1 < 0 ? 0 : (a1 > nrows - 8 ? nrows - 8 : a1); kr_lo = a0; kr_hi = a1 + 7; }
        else { kr_lo = 0; kr_hi = 7; }
        const int nst = kr_hi - kr_lo + 2;
        const int c0 = 16 * ct, c = c0 + i;
        int cw = c0 - 8; cw = cw < 0 ? 0 : (cw > 32 ? 32 : cw);
        int cs = c - 8; cs = cs < 0 ? 0 : (cs > 48 ? 48 : cs);
        if (R < 0) { cw = 0; cs = 0; }
        const int nqr = R < 0 ? 1 : 4;
        int boff[8];
#pragma unroll
        for (int r = 0; r < 4; ++r) { const int k0 = cw + 4 * g + r, k1 = k0 + 16; const bool v0 = (k0 >= cs && k0 <= cs + 15), v1 = (k1 >= cs && k1 <= cs + 15);
            boff[r] = v0 ? (R >= 0 ? k0 - c + 15 : 0) : 31; boff[4 + r] = v1 ? (R >= 0 ? k1 - c + 15 : 0) : 31; }
        bf16x8 qf[4][2];
#pragma unroll
        for (int qr = 0; qr < 4; ++qr) { int row;
            if (R >= 0) row = st0 + (R + qr) * 64 + c; else row = META0 + s * NMETA + i;
#pragma unroll
            for (int kk = 0; kk < 2; ++kk) qf[qr][kk] = *(const bf16x8*)(P + (size_t)row * P_LD + PC_NA + h * 64 + kk * 32 + 8 * g); }
        f32x4 O[4][4]; float lp[4] = {0.f, 0.f, 0.f, 0.f};
#pragma unroll
        for (int qr = 0; qr < 4; ++qr)
#pragma unroll
            for (int dt = 0; dt < 4; ++dt) O[qr][dt] = (f32x4){0.f, 0.f, 0.f, 0.f};
        v4u kv[2][4];
        na_row_load(kv[0], P, s, kr_lo, hp, tz);
        na_row_load(kv[1], P, s, (1 < nst - 1) ? kr_lo + 1 : -1, hp, tz);
        __syncthreads();
        for (int e = tz; e < 2 * 512; e += NTHREADS) { const int hd2 = e >> 9, ro = (e >> 5) & 15, col = e & 31;
            rpbl[e] = col == 31 ? -1e30f : (ro < 15 ? a.in[12][((size_t)layer * 16 + hp * 2 + hd2) * 465 + ro * 31 + col] * LOG2E : 0.f); }
#pragma unroll 1
        for (int b2 = 0; b2 < nst; b2 += 2) {
#pragma unroll
          for (int e = 0; e < 2; ++e) {
            const int b = b2 + e; if (b >= nst) break;
            const int buf = e;
            na_row_store(kv[e], F.lds, buf, tz);
            if (b + 2 < nst) na_row_load(kv[e], P, s, (b + 2 < nst - 1) ? kr_lo + b + 2 : -1, hp, tz);
            __syncthreads();
            const bool ismeta = (b == nst - 1);
            const int kr = kr_lo + b;
            const LAS unsigned char* kb_ = F.lds + buf * NA_STG + hd * 9216;
            const LAS unsigned char* vb_ = kb_ + NA_V;
            const int kc0 = ismeta ? 0 : cw;
            bf16x8 kf0[2], kf1[2];
#pragma unroll
            for (int kk = 0; kk < 2; ++kk) { kf0[kk] = *(const LAS bf16x8*)(kb_ + (kc0 + i) * 144 + (kk * 32 + 8 * g) * 2); kf1[kk] = *(const LAS bf16x8*)(kb_ + (kc0 + 16 + i) * 144 + (kk * 32 + 8 * g) * 2); }
            bf16x8 vf[4];
#pragma unroll
            for (int dt = 0; dt < 4; ++dt) { const LAS unsigned char* ap = vb_ + (kc0 + 4 * g + (i >> 2)) * 144 + (16 * dt + 4 * (i & 3)) * 2; vf[dt] = cat4(lds_tr(ap), lds_tr(ap + 16 * 144)); }
#pragma unroll
            for (int qr = 0; qr < 4; ++qr) {
                if (qr >= nqr) continue;
                int r0 = 0, roff = 15;
                if (R >= 0) { r0 = R + qr - 4; r0 = r0 < 0 ? 0 : (r0 > nrows - 8 ? nrows - 8 : r0); roff = kr - (R + qr) + 7; }
                if (!ismeta && (kr < r0 || kr > r0 + 7)) continue;
                f32x4 t0 = (f32x4){0.f, 0.f, 0.f, 0.f}, t1 = (f32x4){0.f, 0.f, 0.f, 0.f};
#pragma unroll
                for (int kk = 0; kk < 2; ++kk) { t0 = mfma16(kf0[kk], qf[qr][kk], t0); t1 = mfma16(kf1[kk], qf[qr][kk], t1); }
                float m[8]; float ls = 0.f;
                if (ismeta) {
#pragma unroll
                    for (int r = 0; r < 4; ++r) { const float p0 = (4 * g + r < NMETA) ? __builtin_amdgcn_exp2f(fminf(t0[r] * (0.125f * LOG2E), 86.f)) : 0.f; m[r] = p0; m[4 + r] = 0.f; ls += p0; }
                } else {
                    const LAS float* bp = rpbl + hd * 512 + roff * 32;
#pragma unroll
                    for (int r = 0; r < 4; ++r) {
                        const float b0 = bp[boff[r]], b1 = bp[boff[4 + r]];
                        const float a0 = t0[r] * (0.125f * LOG2E) + b0, a1 = t1[r] * (0.125f * LOG2E) + b1;
                        const float p0 = __builtin_amdgcn_exp2f(fminf(a0, 86.f)), p1 = __builtin_amdgcn_exp2f(fminf(a1, 86.f));
                        m[r] = p0; m[4 + r] = p1; ls += p0 + p1;
                    }
                }
                lp[qr] += ls;
                const bf16x8 af = pack8(m);
#pragma unroll
                for (int dt = 0; dt < 4; ++dt) O[qr][dt] = mfma16(vf[dt], af, O[qr][dt]);
            }
            __builtin_amdgcn_sched_barrier(0);
          }
        }
        int lz = F.lane; asm volatile("" : "+v"(lz)); const int g2 = lz >> 4, i2 = lz & 15;
#pragma unroll
        for (int qr = 0; qr < 4; ++qr) {
            if (qr >= nqr) continue;
            float l = lp[qr]; l += __shfl_xor(l, 16); l += __shfl_xor(l, 32);
            const float inv = __builtin_amdgcn_rcpf(l);
            int row; bool ok = true;
            if (R >= 0) row = st0 + (R + qr) * 64 + c0 + i2; else { row = META0 + s * NMETA + i2; ok = (ct == 0); }
            if (ok) {
#pragma unroll
                for (int dt = 0; dt < 4; ++dt) { const f32x4 o = O[qr][dt] * inv; *(v2u*)(XN + (size_t)row * D + 2048 + h * 64 + 16 * dt + 4 * g2) = (v2u){pk2(o[0], o[1]), pk2(o[2], o[3])}; } }
        }
    }
}
__device__ __forceinline__ void p_attn(const Frame& F, KArgs& a, int layer) {
    const int NBG = bg_entries(0, layer);
    DYN_LOOP_BEGIN(q, 1636 + NBG, layer * 4 + 0)
        int u; const int be = bg_split(q, 1636, NBG, u);
        if (be >= 0) { bg_entry(F, a, 0, layer, be); } else {
        int su = -1, nu = -1;
        if (u < 768) su = u; else if (u < 1536) nu = u - 768; else if (u < 1556) su = 768 + (u - 1536); else nu = 768 + (u - 1556);
        if (su >= 0) swa_unit(F, a, layer, su); else na_unit(F, a, layer, nu);
        }
    DYN_LOOP_END(q)
    __syncthreads();
}

constexpr int N_PHASES = 22;
__global__ void __launch_bounds__(NTHREADS, 2) fwd_kernel(Args args_v) {
    extern __shared__ __attribute__((aligned(16))) unsigned char lds[];
#define MKFRAME() Frame F; F.lds = (LAS unsigned char*)lds; F.tid = opaque_tid(wave_s); F.lane = F.tid & 63; F.wave = __builtin_amdgcn_readfirstlane(F.tid >> 6); \
    F.G = gridDim.x; F.gw = blockIdx.x * NWAVES + F.wave; F.NGW = F.G * NWAVES; KArgs* kap = (KArgs*)__builtin_amdgcn_kernarg_segment_ptr(); asm volatile("" : "+s"(kap)); KArgs& args = *kap; F.ws = args.ws; F.out = args.out
    LAS unsigned char* const ldsp = (LAS unsigned char*)lds;
#define GEMM_PTRS() KArgs* kap = (KArgs*)__builtin_amdgcn_kernarg_segment_ptr(); asm volatile("" : "+s"(kap)); unsigned char* ws = kap->ws; float* outp = kap->out; (void)outp
    const int wave_s = __builtin_amdgcn_readfirstlane((int)threadIdx.x >> 6);
    volatile LAS unsigned* MISC = (volatile LAS unsigned*)(ldsp + MISC_OFF);
    for (int u = threadIdx.x; u < (LDS_BYTES - LDSCTL_OFF) / 4; u += NTHREADS) ((LAS unsigned*)(ldsp + LDSCTL_OFF))[u] = 0u;
    __syncthreads();
    unsigned* ctl = (unsigned*)(args_v.ws + WS_CTL);
    const bool multi = (args_v.ph_hi - args_v.ph_lo) > 1;
    if (multi) {
        XcdBarrier bar = xcd_barrier_post(ctl + CW_BAR, MISC + 8);
        if (threadIdx.x == 0) { unsigned nloc, nx; xcd_barrier_complete(ctl + CW_BAR, bar.x, nloc, nx); MISC[8] = nloc; MISC[9] = nx; }
        __syncthreads();
    }
#ifndef PHMASK
#define PHMASK 0xFFF
#endif
#define PHM(k) ((PHMASK >> ((k) == 0 ? 0 : ((k) == 21 ? 11 : (((k) - 1) % 10) + 1))) & 1)
#define KAP_() ((KArgs*)__builtin_amdgcn_kernarg_segment_ptr())
#define IN(k) (PHM(k) && KAP_()->ph_lo <= (k) && (k) < KAP_()->ph_hi)
#define BAR_() do { XcdBarrier b_; b_.bar = (unsigned*)(KAP_()->ws + WS_CTL) + CW_BAR; b_.x = xb_xcc_id(); b_.st = (volatile LAS unsigned*)((LAS unsigned char*)lds + MISC_OFF) + 8; xcd_barrier(b_, wave_s == 0 && opaque_lane() == 0); } while (0)
#define SEAM(k) do { if (IN(k) && IN((k) + 1)) BAR_(); } while (0)
#ifndef REPMASK
#define REPMASK 0
#endif
#define REPM(k) ((REPMASK >> ((k) == 0 ? 0 : ((k) == 21 ? 11 : (((k) - 1) % 10) + 1))) & 1)
#define RUN2(k, body) do { { body; } if (REPM(k)) { BAR_(); { body; } } } while (0)
    if (IN(0)) { RUN2(0, MKFRAME(); p_prologue(F, args)); SEAM(0); }
#define LAYER_BODY(layer) do { \
        const int pb = 1 + 10 * layer; \
        if (IN(pb + 0)) { if (layer > 0) { MKFRAME(); p_norm_meta(F, 2 * layer); SEAM(pb + 0); } } \
        if (IN(pb + 1)) { \
            GEMM_PTRS(); \
            pg8::Gemm g{(const bf16*)(ws + WS_HB), (const bf16*)(ws + WS_WIN + layer * SZ_WIN), MP, IN_N, D}; \
            pg8::StaticOrder S; S.init(IN_N, D, 1, (int)gridDim.x, (int)blockIdx.x); \
            pg8::EpiInProj E{(bf16*)(ws + WS_P), (float*)(ws + WS_DT), (const float*)(ws + WS_RSTD) + (size_t)(2 * layer) * MP}; \
            RUN2(pb + 1, (pg8::gemm_phase<pg8::EpiInProj, pg8::StaticOrder, true, true>(ldsp + RING_OFF, g, S, E, wave_s))); \
            SEAM(pb + 1); \
        } \
        if (IN(pb + 2)) { RUN2(pb + 2, { MKFRAME(); p_ssd_prep(F, args, layer); } { MKFRAME(); p_attn(F, args, layer); }); SEAM(pb + 2); } \
        if (IN(pb + 3)) { RUN2(pb + 3, MKFRAME(); p_scanA(F, args, layer)); SEAM(pb + 3); } \
        if (IN(pb + 4)) { RUN2(pb + 4, MKFRAME(); p_scanB(F, args)); SEAM(pb + 4); } \
        if (IN(pb + 5)) { RUN2(pb + 5, MKFRAME(); p_scanC(F, args, layer)); SEAM(pb + 5); } \
        if (IN(pb + 6)) { \
            GEMM_PTRS(); \
            pg8::Gemm g{(const bf16*)(ws + WS_XN), (const bf16*)(ws + WS_WOUT + layer * SZ_WOUT), MP, D, D}; \
            pg8::StaticOrder S; S.init(D, D, 16, (int)gridDim.x, (int)blockIdx.x); \
            pg8::EpiResid E{(bf16*)(ws + WS_HB), (float*)(ws + WS_SLAB), D / 64, (float*)(ws + WS_SSP), nullptr}; \
            pg8::gemm_phase<pg8::EpiResid, pg8::StaticOrder, true, true>(ldsp + RING_OFF, g, S, E, wave_s); \
            SEAM(pb + 6); \
        } \
        if (IN(pb + 7)) { MKFRAME(); p_norm_meta(F, 2 * layer + 1); SEAM(pb + 7); } \
        if (IN(pb + 8)) { \
            GEMM_PTRS(); \
            pg8::Gemm g{(const bf16*)(ws + WS_HB), (const bf16*)(ws + WS_WUP + layer * SZ_WUP), MP, FF, D}; \
            pg8::StaticOrder S; S.init(FF, D, 1, (int)gridDim.x, (int)blockIdx.x); \
            pg8::EpiUp E{(bf16*)(ws + WS_HID), (const float*)(ws + WS_RSTD) + (size_t)(2 * layer + 1) * MP}; \
            RUN2(pb + 8, (pg8::gemm_phase<pg8::EpiUp, pg8::StaticOrder, true, true>(ldsp + RING_OFF, g, S, E, wave_s))); \
            SEAM(pb + 8); \
        } \
        if (IN(pb + 9)) { \
            GEMM_PTRS(); \
            pg8::Gemm g{(const bf16*)(ws + WS_HID), (const bf16*)(ws + WS_WDN + layer * SZ_WDN), MP, D, FF}; \
            pg8::StaticOrder S; S.init(D, FF, 16, (int)gridDim.x, (int)blockIdx.x); \
            pg8::EpiResid E{(bf16*)(ws + WS_HB), (float*)(ws + WS_SLAB), FF / 64, (float*)(ws + WS_SSP), nullptr}; \
            pg8::gemm_phase<pg8::EpiResid, pg8::StaticOrder, true, true>(ldsp + RING_OFF, g, S, E, wave_s); \
            SEAM(pb + 9); \
        } \
     \
    } while (0)
    LAYER_BODY(0);
    LAYER_BODY(1);
#undef LAYER_BODY
    if (IN(21)) { MKFRAME(); p_final_norm(F, args); }
#undef IN
#undef SEAM
}

extern "C" void kernel_launch(void* const* d_in, const int* in_sizes, int n_in, void* d_out, int out_size, void* d_ws, size_t ws_size, hipStream_t stream) {
    static int grid = 0;
    if (grid == 0) {
        if (n_in != 19 || ws_size < WS_END) { fprintf(stderr, "kernel_launch: unexpected shapes (n_in %d, ws %zu, need %zu)\n", n_in, ws_size, (size_t)WS_END); grid = -1; return; }
        int dev = 0, cus = 0, per_cu = 0;
        if (hipGetDevice(&dev) != hipSuccess || hipDeviceGetAttribute(&cus, hipDeviceAttributeMultiprocessorCount, dev) != hipSuccess) { grid = -1; return; }
        if (hipFuncSetAttribute((const void*)fwd_kernel, hipFuncAttributeMaxDynamicSharedMemorySize, LDS_BYTES) != hipSuccess) { fprintf(stderr, "kernel_launch: hipFuncSetAttribute failed\n"); grid = -1; return; }
        if (hipOccupancyMaxActiveBlocksPerMultiprocessor(&per_cu, (const void*)fwd_kernel, NTHREADS, LDS_BYTES) != hipSuccess || per_cu < 1) { fprintf(stderr, "kernel_launch: occupancy query says %d\n", per_cu); }
        (void)hipGetLastError();
        grid = cus;
    }
    if (grid < 0) return;
    (void)hipMemsetAsync((char*)d_ws + WS_CTL, 0, CTL_ZERO_BYTES, stream);
    Args a{};
    for (int i = 0; i < 19; ++i) a.in[i] = (const float*)d_in[i];
    a.out = (float*)d_out; a.ws = (unsigned char*)d_ws;
#if N_LAUNCH_MODE == 1
    a.ph_lo = 0; a.ph_hi = N_PHASES;
    hipLaunchKernelGGL(fwd_kernel, dim3(grid), dim3(NTHREADS), LDS_BYTES, stream, a);
#else
    for (int ph = 0; ph < N_PHASES; ++ph) {
        a.ph_lo = ph; a.ph_hi = ph + 1;
        hipLaunchKernelGGL(fwd_kernel, dim3(grid), dim3(NTHREADS), LDS_BYTES, stream, a);
    }
#endif
}
```

```cpp
#include <hip/hip_runtime.h>
#include <cstdio>
#include <cstdint>

#ifndef N_LAUNCH_MODE
#define N_LAUNCH_MODE 1
#endif

constexpr int D = 4096, FF = 16384;
constexpr int NREAL = 24576, NSEQ = 10, NMETA = 16, MP = 24832;
constexpr int META0 = NREAL;
constexpr int NTOK = NREAL + NSEQ * NMETA;
constexpr int IN_N = 10496, P_LD = 10240;
constexpr int IN_SRC = 10272;
constexpr int PC_Z = 0, PC_XBC = 1024, PC_SWA = 2560, PC_NA = 4096, PC_RET = 7168;
constexpr float EPS = 1e-6f;

constexpr size_t MiB = 1u << 20;
constexpr size_t WS_CTL = 0, CTL_ZERO_BYTES = 65536;
constexpr size_t SZ_WIN = (size_t)IN_N * D * 2, SZ_WOUT = (size_t)D * D * 2, SZ_WUP = (size_t)FF * D * 2, SZ_WDN = (size_t)D * FF * 2;
constexpr size_t WS_WIN = 8 * MiB;
constexpr size_t WS_WOUT = WS_WIN + 2 * SZ_WIN;
constexpr size_t WS_WUP = WS_WOUT + 2 * SZ_WOUT;
constexpr size_t WS_WDN = WS_WUP + 2 * SZ_WUP;
constexpr size_t WS_HM = WS_WDN + 2 * SZ_WDN;
constexpr size_t WS_XN = WS_HM + (size_t)256 * D * 4;
constexpr size_t WS_HB = WS_XN + (size_t)MP * D * 2;
constexpr size_t WS_BIG = WS_HB + (size_t)MP * D * 2;
constexpr size_t WS_P = WS_BIG;
constexpr size_t WS_DT = WS_P + (size_t)MP * P_LD * 2;
constexpr size_t WS_DTL = WS_DT + (size_t)MP * 32 * 4;
constexpr size_t WS_XBC = WS_DTL + (size_t)MP * 64 * 4;
constexpr size_t WS_LOC = WS_XBC + (size_t)MP * 1536 * 2;
constexpr size_t WS_SIN = WS_LOC + (size_t)202 * 24 * 2 * 8192 * 2;
constexpr size_t WS_CDEC = WS_SIN + (size_t)202 * 24 * 2 * 8192 * 2;
constexpr size_t WS_BIG_END1 = WS_CDEC + (size_t)202 * 24 * 2 * 4;
constexpr size_t WS_HID = WS_BIG;
constexpr size_t WS_SLAB = WS_HID + (size_t)MP * FF * 2;
constexpr size_t WS_BIG_END2 = WS_SLAB + (size_t)16 * 256 * D * 4;
constexpr size_t WS_END = WS_BIG_END1 > WS_BIG_END2 ? WS_BIG_END1 : WS_BIG_END2;
static_assert(WS_END <= (size_t)2048 * MiB, "workspace map must fit 2 GiB");

constexpr int CW_BAR = 4096;
constexpr size_t WS_RSTD = 65536;
constexpr size_t WS_SSP = WS_RSTD + (size_t)4 * MP * 4;
static_assert(WS_SSP + (size_t)MP * 64 * 4 <= 8 * MiB, "control region");

constexpr int RING_OFF = 0, RING_BYTES = 131072;
constexpr int LDSCTL_OFF = RING_BYTES, MISC_OFF = LDSCTL_OFF + 320;
constexpr int LDS_BYTES = 147456;
constexpr int NWAVES = 8, NTHREADS = 512;

#define GAS __attribute__((address_space(1)))
#define LAS __attribute__((address_space(3)))
typedef unsigned short bf16;
typedef unsigned v4u __attribute__((ext_vector_type(4)));
typedef unsigned v2u __attribute__((ext_vector_type(2)));
typedef float f32x4 __attribute__((ext_vector_type(4)));
typedef float f32x2 __attribute__((ext_vector_type(2)));
typedef short bf16x8 __attribute__((ext_vector_type(8)));

__device__ __forceinline__ unsigned pk2(float lo, float hi) { unsigned r; asm("v_cvt_pk_bf16_f32 %0, %1, %2" : "=v"(r) : "v"(lo), "v"(hi)); return r; }
__device__ __forceinline__ unsigned f2bf(float f) { return pk2(f, 0.f) & 0xffffu; }
__device__ __forceinline__ float bflo(unsigned w) { return __builtin_bit_cast(float, w << 16); }
__device__ __forceinline__ float bfhi(unsigned w) { return __builtin_bit_cast(float, w & 0xffff0000u); }
__device__ __forceinline__ float bf1(bf16 b) { return __builtin_bit_cast(float, (unsigned)b << 16); }
__device__ __forceinline__ void unpack8(const v4u w, float (&f)[8]) {
    f[0] = bflo(w.x); f[1] = bfhi(w.x); f[2] = bflo(w.y); f[3] = bfhi(w.y); f[4] = bflo(w.z); f[5] = bfhi(w.z); f[6] = bflo(w.w); f[7] = bfhi(w.w);
}
__device__ __forceinline__ float siluf(float x) { return x * __builtin_amdgcn_rcpf(1.f + __expf(-x)); }
__device__ __forceinline__ float wave_sum(float v) {
#pragma unroll
    for (int o = 1; o < 64; o <<= 1) v += __shfl_xor(v, o);
    return v;
}
#define LDS_WAIT() asm volatile("s_waitcnt lgkmcnt(0)" ::: "memory")

__device__ __forceinline__ int seq_start(int s) { return s < 2 ? s * 4096 : 8192 + (s - 2) * 2048; }
__device__ __forceinline__ int seq_T(int s) { return s < 2 ? 4096 : 2048; }
__device__ __forceinline__ int seq_of_real(int r) { return r < 8192 ? (r >> 12) : 2 + ((r - 8192) >> 11); }
__device__ __forceinline__ int row_of(int s, int l) { return l < NMETA ? META0 + s * NMETA + l : seq_start(s) + l - NMETA; }

__device__ __forceinline__ int opaque_lane() { int t; asm volatile("v_mbcnt_lo_u32_b32 %0, -1, 0\n\tv_mbcnt_hi_u32_b32 %0, -1, %0" : "=v"(t)); return t; }
__device__ __forceinline__ int opaque_tid(int wave_s) { return (wave_s << 6) | opaque_lane(); }
namespace pg8 {
#define PG8_LAS __attribute__((address_space(3)))
typedef unsigned short bf16_t;
typedef short bf16x8 __attribute__((ext_vector_type(8)));
typedef float f32x4 __attribute__((ext_vector_type(4)));
typedef unsigned u32x4 __attribute__((ext_vector_type(4)));
constexpr int BM = 256, BK = 64, HALF = 128, HTB = HALF * BK * 2, STAGE_BYTES = 8 * HTB, NXCD = 8, WGM = 8;

__host__ __device__ __forceinline__ int lds_byte(int r, int c) { const int st = (r >> 4) * 2 + (c >> 5), rr = r & 15, cc = c & 31, ob = rr * 64 + cc * 2; return st * 1024 + (ob ^ (((ob >> 9) & 1) << 5)); }
__host__ __device__ __forceinline__ void stage_rc(int b, int& R, int& C) { const int st = b / 1024, sb = b % 1024, swz = sb ^ (((sb >> 9) & 1) << 5); R = (st >> 1) * 16 + swz / 64; C = (st & 1) * 32 + (swz % 64) / 2; }
__host__ __device__ __forceinline__ int perm32(int rho) { const int n = rho >> 4, i = rho & 15; return 8 * (i >> 2) + 4 * n + (i & 3); }

struct Unit { int pm, pn, kt0, nkt; };
struct Gemm { const bf16_t* A; const bf16_t* Bt; int M, N, K; };

struct StaticOrder {
    int nM, nN, nwg, G, c, nt, split;
    __host__ __device__ void init(int N, int K, int split_, int G_, int c_) { nM = 96; nN = N / BM; nwg = nM * nN; G = G_; c = c_; nt = K / BK; split = split_; }
    __host__ __device__ bool next(int i, Unit& u) const {
        const int L = i * G + c;
        if (L >= nwg + nN * split) return false;
        const bool ex = L >= nwg;
        const int e = ex ? L - nwg : 0;
        int wgid = ex ? 0 : L; { const int q = nwg / NXCD, r = nwg % NXCD, xcd = wgid % NXCD, off = wgid / NXCD; wgid = (xcd < r ? xcd * (q + 1) : r * (q + 1) + (xcd - r) * q) + off; }
        const int nig = WGM * nN, gid = wgid / nig, fm = gid * WGM, gsz = (nM - fm) < WGM ? (nM - fm) : WGM;
        int pm_m = fm + ((wgid % nig) % gsz), pn_m = (wgid % nig) / gsz;
        if (nN == 16 && G == 256) {
            const int xcd = c & 7, j = c >> 3; pm_m = 8 * (2 * i + (xcd >> 2)) + (j & 7); pn_m = 4 * (xcd & 3) + (j >> 3); }
        if (nN == 64 && G == 256) {
            const int xcd = c & 7, j = c >> 3; pm_m = 4 * i + (j & 3); pn_m = 8 * xcd + (j >> 2); }
        const int nk_e = nt / split;
        u.pm = ex ? 96 : pm_m; u.pn = ex ? e / split : pn_m; u.nkt = ex ? nk_e : nt; u.kt0 = ex ? (e % split) * nk_e : 0;
        return true;
    }
    __device__ __forceinline__ void a_ready(const Unit&) const {}
    __device__ __forceinline__ void done(const Unit&) const {}
};

__device__ __forceinline__ unsigned cvt_pk_bf16(float lo, float hi) { unsigned r; asm volatile("v_cvt_pk_bf16_f32 %0, %1, %2" : "=v"(r) : "v"(lo), "v"(hi)); return r; }


struct EpiInProj {
    static constexpr bool PERM = true, AFTER_DRAIN = false;
    bf16_t* P; float* DT; const float* rstd;
    static constexpr bool NEED_RS = true;
    __device__ __forceinline__ void operator()(const f32x4 (&acc)[2][2][4][2], const Unit& u, int wr, int wc, const PG8_LAS float* rsl, int) const {
        const int ln = opaque_lane(), fr = ln & 15, fq = ln >> 4;
        const int row0 = u.pm * BM + wr * 64 + fr;
        float rs[2][4];
#pragma unroll
        for (int ai = 0; ai < 2; ++ai)
#pragma unroll
            for (int m = 0; m < 4; ++m) rs[ai][m] = rsl[wr * 64 + fr + ai * HALF + m * 16];
        if (u.pn < 40) {
            const int col0 = u.pn * BM + wc * 32 + 8 * fq;
#pragma unroll
            for (int ai = 0; ai < 2; ++ai)
#pragma unroll
                for (int m = 0; m < 4; ++m) { bf16_t* rowp = P + (size_t)(row0 + ai * HALF + m * 16) * P_LD + col0;
#pragma unroll
                    for (int bj = 0; bj < 2; ++bj) { const f32x4 v0 = acc[ai][bj][m][0] * rs[ai][m], v1 = acc[ai][bj][m][1] * rs[ai][m];
                        u32x4 w; w.x = cvt_pk_bf16(v0[0], v0[1]); w.y = cvt_pk_bf16(v0[2], v0[3]); w.z = cvt_pk_bf16(v1[0], v1[1]); w.w = cvt_pk_bf16(v1[2], v1[3]);
                        *(u32x4*)(rowp + bj * HALF) = w; } }
        } else if (wc == 0) {
#pragma unroll
            for (int ai = 0; ai < 2; ++ai)
#pragma unroll
                for (int m = 0; m < 4; ++m) { float* rowp = DT + (size_t)(row0 + ai * HALF + m * 16) * 32 + 8 * fq;
                    *(f32x4*)(rowp) = acc[ai][0][m][0] * rs[ai][m]; *(f32x4*)(rowp + 4) = acc[ai][0][m][1] * rs[ai][m]; }
        }
    }
};
struct EpiResid {
    static constexpr bool PERM = true, AFTER_DRAIN = false;
    bf16_t* HB; float* slab; int fullkt; float* ssp; const float* rstd;
    static constexpr bool NEED_RS = false;
    __device__ __forceinline__ void operator()(const f32x4 (&acc)[2][2][4][2], const Unit& u, int wr, int wc, const PG8_LAS float*, int) const {
        const int ln = opaque_lane(), fr = ln & 15, fq = ln >> 4;
        const int rloc = wr * 64 + fr, col0 = u.pn * BM + wc * 32 + 8 * fq;
        if (u.nkt == fullkt) {
            u32x4 old[2][4][2];
#pragma unroll
            for (int ai = 0; ai < 2; ++ai)
#pragma unroll
                for (int m = 0; m < 4; ++m) { const bf16_t* hp = HB + (size_t)(u.pm * BM + rloc + ai * HALF + m * 16) * D + col0;
#pragma unroll
                    for (int bj = 0; bj < 2; ++bj) old[ai][m][bj] = *(const u32x4*)(hp + bj * HALF); }
#pragma unroll
            for (int ai = 0; ai < 2; ++ai)
#pragma unroll
                for (int m = 0; m < 4; ++m) { const int row = u.pm * BM + rloc + ai * HALF + m * 16; bf16_t* hp = HB + (size_t)row * D + col0; float sq = 0.f;
#pragma unroll
                    for (int bj = 0; bj < 2; ++bj) { const u32x4 o = old[ai][m][bj];
                        f32x4 v0 = acc[ai][bj][m][0], v1 = acc[ai][bj][m][1];
                        v0[0] += __builtin_bit_cast(float, o.x << 16); v0[1] += __builtin_bit_cast(float, o.x & 0xffff0000u); v0[2] += __builtin_bit_cast(float, o.y << 16); v0[3] += __builtin_bit_cast(float, o.y & 0xffff0000u);
                        v1[0] += __builtin_bit_cast(float, o.z << 16); v1[1] += __builtin_bit_cast(float, o.z & 0xffff0000u); v1[2] += __builtin_bit_cast(float, o.w << 16); v1[3] += __builtin_bit_cast(float, o.w & 0xffff0000u);
                        sq += ((v0[0] * v0[0] + v0[1] * v0[1]) + (v0[2] * v0[2] + v0[3] * v0[3])) + ((v1[0] * v1[0] + v1[1] * v1[1]) + (v1[2] * v1[2] + v1[3] * v1[3]));
                        u32x4 w; w.x = cvt_pk_bf16(v0[0], v0[1]); w.y = cvt_pk_bf16(v0[2], v0[3]); w.z = cvt_pk_bf16(v1[0], v1[1]); w.w = cvt_pk_bf16(v1[2], v1[3]);
                        *(u32x4*)(hp + bj * HALF) = w; }
                    sq += __shfl_xor(sq, 16); sq += __shfl_xor(sq, 32);
                    if (fq == 0) ssp[(size_t)row * 64 + u.pn * 4 + wc] = sq; }
        } else {
            const int ks = u.kt0 / u.nkt;
#pragma unroll
            for (int ai = 0; ai < 2; ++ai)
#pragma unroll
                for (int m = 0; m < 4; ++m) { float* rowp = slab + ((size_t)ks * 256 + rloc + ai * HALF + m * 16) * D + col0;
#pragma unroll
                    for (int bj = 0; bj < 2; ++bj) { *(f32x4*)(rowp + bj * HALF) = acc[ai][bj][m][0]; *(f32x4*)(rowp + bj * HALF + 4) = acc[ai][bj][m][1]; } }
        }
    }
};
struct EpiUp {
    static constexpr bool PERM = true, AFTER_DRAIN = false;
    bf16_t* O; const float* rstd;
    static constexpr bool NEED_RS = true;
    __device__ __forceinline__ void operator()(const f32x4 (&acc)[2][2][4][2], const Unit& u, int wr, int wc, const PG8_LAS float* rsl, int) const {
        const int ln = opaque_lane(), fr = ln & 15, fq = ln >> 4;
        const int row0 = u.pm * BM + wr * 64 + fr, col0 = u.pn * BM + wc * 32 + 8 * fq;
#pragma unroll
        for (int ai = 0; ai < 2; ++ai)
#pragma unroll
            for (int m = 0; m < 4; ++m) { bf16_t* rowp = O + (size_t)(row0 + ai * HALF + m * 16) * FF + col0;
                const float rs = rsl[wr * 64 + fr + ai * HALF + m * 16];
#pragma unroll
                for (int bj = 0; bj < 2; ++bj) { f32x4 v0 = acc[ai][bj][m][0] * rs, v1 = acc[ai][bj][m][1] * rs;
                    v0 = __builtin_elementwise_max(v0, (f32x4){0.f, 0.f, 0.f, 0.f}); v1 = __builtin_elementwise_max(v1, (f32x4){0.f, 0.f, 0.f, 0.f}); v0 = v0 * v0; v1 = v1 * v1;
                    u32x4 w; w.x = cvt_pk_bf16(v0[0], v0[1]); w.y = cvt_pk_bf16(v0[2], v0[3]); w.z = cvt_pk_bf16(v1[0], v1[1]); w.w = cvt_pk_bf16(v1[2], v1[3]);
                    *(u32x4*)(rowp + bj * HALF) = w; } }
    }
};

template <class Epi, class Sched, bool ALIGN_EPI = false, bool SP2 = false>
__device__ __forceinline__ void gemm_phase(PG8_LAS unsigned char* lds, const Gemm g, const Sched& S, const Epi& E, int wave_s) {
    const int tid = opaque_tid(wave_s), wid = __builtin_amdgcn_readfirstlane(tid >> 6), lane = tid & 63, wr = wid >> 2, wc = wid & 3, fr = lane & 15, fq = lane >> 4;
    const int K = g.K;
    unsigned voffA[2], voffB[2];
#pragma unroll
    for (int i = 0; i < 2; ++i) { int R, C; stage_rc(tid * 16 + i * 8192, R, C); const int Rb = Epi::PERM ? ((R & ~31) + perm32(R & 31)) : R;
        voffA[i] = (unsigned)(R * K + C) * 2u; voffB[i] = (unsigned)(Rb * K + C) * 2u; }
    const size_t kstep = (size_t)(BK * 2);
    const size_t hstep = (size_t)HALF * K * 2;
    const size_t tstep = 2 * hstep;
    const unsigned ldsw = (unsigned)wid * 1024u;
    const int aoff = lds_byte(wr * 64 + fr, fq * 8), boff = lds_byte(wc * 32 + fr, fq * 8);
#define PG8_SA(b, h) (((b) * 2 + (h)) * HTB)
#define PG8_SB(b, h) ((4 + (b) * 2 + (h)) * HTB)
#define PG8_STAGE(bufoff, gbase, voff) do { _Pragma("unroll") for (int _i = 0; _i < 2; ++_i) \
        __builtin_amdgcn_global_load_lds((const unsigned*)((const char*)(gbase) + (voff)[_i]), (PG8_LAS unsigned*)(lds + (bufoff) + ldsw + _i * 8192), 16, 0, 0); } while (0)
#define PG8_LDA(dst, b, h) do { _Pragma("unroll") for (int m = 0; m < 4; ++m) _Pragma("unroll") for (int k = 0; k < 2; ++k) dst[m][k] = *(const PG8_LAS bf16x8*)(lds + PG8_SA(b, h) + aoff + m * 2048 + k * 1024); } while (0)
#define PG8_LDB(dst, b, h) do { _Pragma("unroll") for (int n = 0; n < 2; ++n) _Pragma("unroll") for (int k = 0; k < 2; ++k) dst[n][k] = *(const PG8_LAS bf16x8*)(lds + PG8_SB(b, h) + boff + n * 2048 + k * 1024); } while (0)
#define PG8_MMA(ai, bj, At, Bt) do { __builtin_amdgcn_s_setprio(1); _Pragma("unroll") for (int m = 0; m < 4; ++m) _Pragma("unroll") for (int n = 0; n < 2; ++n) _Pragma("unroll") for (int k = 0; k < 2; ++k) \
        acc[ai][bj][m][n] = __builtin_amdgcn_mfma_f32_16x16x32_bf16(Bt[n][k], At[m][k], acc[ai][bj][m][n], 0, 0, 0); __builtin_amdgcn_s_setprio(0); } while (0)
#define PG8_WAIT_V(n) asm volatile("s_waitcnt vmcnt(" #n ")" ::: "memory")
#define PG8_WAIT_L(n) asm volatile("s_waitcnt lgkmcnt(" #n ")" ::: "memory")
#define PG8_BAR __builtin_amdgcn_s_barrier()
#define PG8_SCHED __builtin_amdgcn_sched_barrier(0)
    Unit cur, nxt; int ui = 0;
    if (!S.next(0, cur)) return;
    f32x4 acc[2][2][4][2];
#pragma unroll
    for (int a = 0; a < 2; ++a)
#pragma unroll
        for (int b = 0; b < 2; ++b)
#pragma unroll
            for (int m = 0; m < 4; ++m)
#pragma unroll
                for (int n = 0; n < 2; ++n) acc[a][b][m][n] = (f32x4){0.f, 0.f, 0.f, 0.f};
    bf16x8 At[4][2], B0[2][2], B1[2][2];
    const char* cA = (const char*)g.A + (size_t)cur.pm * tstep + (size_t)cur.kt0 * kstep; const char* cB = (const char*)g.Bt + (size_t)cur.pn * tstep + (size_t)cur.kt0 * kstep;
    S.a_ready(cur);
    if constexpr (SP2) {
        PG8_STAGE(PG8_SB(0, 0), cB, voffB); PG8_STAGE(PG8_SB(0, 1), cB + hstep, voffB); PG8_STAGE(PG8_SA(0, 0), cA, voffA); PG8_STAGE(PG8_SA(0, 1), cA + hstep, voffA);
        if (wr == 1) PG8_BAR;
        PG8_WAIT_V(2); PG8_BAR;
        PG8_STAGE(PG8_SB(1, 0), cB + kstep, voffB); PG8_STAGE(PG8_SA(1, 0), cA + kstep, voffA); PG8_STAGE(PG8_SB(1, 1), cB + hstep + kstep, voffB);
        PG8_WAIT_V(6); PG8_BAR;
    } else {
        PG8_STAGE(PG8_SB(0, 0), cB, voffB); PG8_STAGE(PG8_SA(0, 0), cA, voffA); PG8_STAGE(PG8_SB(0, 1), cB + hstep, voffB); PG8_STAGE(PG8_SA(0, 1), cA + hstep, voffA);
        if (wr == 1) PG8_BAR;
        PG8_WAIT_V(4); PG8_BAR;
        PG8_STAGE(PG8_SB(1, 0), cB + kstep, voffB); PG8_STAGE(PG8_SA(1, 0), cA + kstep, voffA); PG8_STAGE(PG8_SB(1, 1), cB + hstep + kstep, voffB);
        PG8_WAIT_V(6); PG8_BAR;
    }
    for (;;) {
        const bool has_next = S.next(ui + 1, nxt);
        const char* nA = has_next ? (const char*)g.A + (size_t)nxt.pm * tstep + (size_t)nxt.kt0 * kstep : cA; const char* nB = has_next ? (const char*)g.Bt + (size_t)nxt.pn * tstep + (size_t)nxt.kt0 * kstep : cB;
        const int nt = cur.nkt;
        PG8_LAS float* rsl = (PG8_LAS float*)(lds + STAGE_BYTES + 2048 + (ui & 1) * 1024);
        for (int t = 0; t < nt; t += 2) {
            const bool last = (t == nt - 2);
            if constexpr (Epi::NEED_RS) { if (t == 0 && wid < 4) __builtin_amdgcn_global_load_lds((const unsigned*)(E.rstd + cur.pm * BM + wid * 64 + lane), (PG8_LAS unsigned*)(rsl + wid * 64), 4, 0, 0); }
            const char* a1 = cA + (size_t)(t + 1) * kstep;
            const char* a2 = last ? nA : cA + (size_t)(t + 2) * kstep; const char* b2 = last ? nB : cB + (size_t)(t + 2) * kstep;
            const char* a3 = a2 + kstep; const char* b3 = b2 + kstep;
            if (last && has_next) S.a_ready(nxt);
            if constexpr (SP2) {
            PG8_LDB(B0, 0, 0); PG8_LDB(B1, 0, 1); PG8_SCHED; PG8_LDA(At, 0, 0); PG8_STAGE(PG8_SA(1, 1), a1 + hstep, voffA);
            PG8_WAIT_V(8); PG8_WAIT_L(0); PG8_BAR; PG8_MMA(0, 0, At, B0); PG8_MMA(0, 1, At, B1); PG8_BAR; PG8_SCHED;
            PG8_LDA(At, 0, 1); PG8_STAGE(PG8_SB(0, 0), b2, voffB); PG8_STAGE(PG8_SB(0, 1), b2 + hstep, voffB); PG8_STAGE(PG8_SA(0, 0), a2, voffA);
            PG8_WAIT_V(8); PG8_WAIT_L(0); PG8_BAR; PG8_MMA(1, 0, At, B0); PG8_MMA(1, 1, At, B1); PG8_BAR; PG8_SCHED;
            PG8_LDB(B0, 1, 0); PG8_LDB(B1, 1, 1); PG8_SCHED; PG8_LDA(At, 1, 0); PG8_STAGE(PG8_SA(0, 1), a2 + hstep, voffA);
            PG8_WAIT_V(8); PG8_WAIT_L(0); PG8_BAR; PG8_MMA(0, 0, At, B0); PG8_MMA(0, 1, At, B1); PG8_BAR; PG8_SCHED;
            PG8_LDA(At, 1, 1); PG8_STAGE(PG8_SB(1, 0), b3, voffB); PG8_STAGE(PG8_SB(1, 1), b3 + hstep, voffB); PG8_STAGE(PG8_SA(1, 0), a3, voffA);
            PG8_WAIT_V(8); PG8_WAIT_L(0); PG8_BAR; PG8_MMA(1, 0, At, B0); PG8_MMA(1, 1, At, B1); PG8_BAR; PG8_SCHED;
            } else {
            PG8_LDB(B0, 0, 0); PG8_SCHED; PG8_LDA(At, 0, 0); PG8_STAGE(PG8_SA(1, 1), a1 + hstep, voffA);
            PG8_WAIT_L(8); PG8_BAR; PG8_WAIT_L(0); PG8_MMA(0, 0, At, B0); PG8_BAR; PG8_SCHED;
            PG8_LDB(B1, 0, 1); PG8_STAGE(PG8_SB(0, 0), b2, voffB);
            PG8_BAR; PG8_WAIT_L(0); PG8_MMA(0, 1, At, B1); PG8_BAR;
            PG8_LDA(At, 0, 1); PG8_STAGE(PG8_SA(0, 0), a2, voffA);
            PG8_BAR; PG8_WAIT_L(0); PG8_MMA(1, 0, At, B0); PG8_BAR; PG8_SCHED;
            PG8_STAGE(PG8_SB(0, 1), b2 + hstep, voffB);
            PG8_WAIT_V(6); PG8_BAR; PG8_MMA(1, 1, At, B1); PG8_BAR;
            PG8_LDB(B0, 1, 0); PG8_SCHED; PG8_LDA(At, 1, 0); PG8_STAGE(PG8_SA(0, 1), a2 + hstep, voffA);
            PG8_WAIT_L(8); PG8_BAR; PG8_WAIT_L(0); PG8_MMA(0, 0, At, B0); PG8_BAR; PG8_SCHED;
            PG8_LDB(B1, 1, 1); PG8_STAGE(PG8_SB(1, 0), b3, voffB);
            PG8_BAR; PG8_WAIT_L(0); PG8_MMA(0, 1, At, B1); PG8_BAR;
            PG8_LDA(At, 1, 1); PG8_STAGE(PG8_SA(1, 0), a3, voffA);
            PG8_BAR; PG8_WAIT_L(0); PG8_MMA(1, 0, At, B0); PG8_BAR; PG8_SCHED;
            PG8_STAGE(PG8_SB(1, 1), b3 + hstep, voffB);
            PG8_WAIT_V(6); PG8_BAR; PG8_MMA(1, 1, At, B1); PG8_BAR;
            }
        }
        if constexpr (ALIGN_EPI) { if (wr == 0) PG8_BAR; }
        E(acc, cur, wr, wc, rsl, 0); S.done(cur);
        if (!has_next) break;
#pragma unroll
        for (int a = 0; a < 2; ++a)
#pragma unroll
            for (int b = 0; b < 2; ++b)
#pragma unroll
                for (int m = 0; m < 4; ++m)
#pragma unroll
                    for (int n = 0; n < 2; ++n) acc[a][b][m][n] = (f32x4){0.f, 0.f, 0.f, 0.f};
        cur = nxt; cA = nA; cB = nB; ++ui;
        if constexpr (ALIGN_EPI) { if (wr == 1) PG8_BAR; }
    }
    PG8_WAIT_V(0);
    if constexpr (!ALIGN_EPI) { if (wr == 0) PG8_BAR; }
    PG8_BAR;
#undef PG8_SA
#undef PG8_SB
#undef PG8_STAGE
#undef PG8_LDA
#undef PG8_LDB
#undef PG8_MMA
#undef PG8_WAIT_V
#undef PG8_WAIT_L
#undef PG8_BAR
#undef PG8_SCHED
}
}

#define XB_TMO      128
#define XB_XCNT(j)  (256  + 64 * (j))
#define XB_XSUB(j)  (1280 + 64 * (j))
#define XB_XGEN(j)  (2304 + 64 * (j))
#define XB_TOP      3328
#define XB_TOPGEN   3392
#define XCD_BAR_WORDS 3456
#define XB_SPIN_CAP (1u << 18)

__device__ __forceinline__ unsigned xb_ld(unsigned* p)              { return __hip_atomic_load(p, __ATOMIC_RELAXED, __HIP_MEMORY_SCOPE_AGENT); }
__device__ __forceinline__ unsigned xb_add(unsigned* p, unsigned v) { return __hip_atomic_fetch_add(p, v, __ATOMIC_RELAXED, __HIP_MEMORY_SCOPE_AGENT); }
__device__ __forceinline__ unsigned xb_xcc_id() { return (unsigned)__builtin_amdgcn_s_getreg((3 << 11) | 20) & 0xFu; }
#define XB_SPIN(cond, bar) do { unsigned _sp = 0; while (cond) { __builtin_amdgcn_s_sleep(1); \
    if ((++_sp & 255u) == 0u) { if (xb_ld(&(bar)[XB_TMO])) break; if (_sp > XB_SPIN_CAP) { atomicAdd(&(bar)[XB_TMO], 1u); break; } } } } while (0)

struct XcdBarrier {
    unsigned* bar; unsigned x;
    volatile LAS unsigned* st;
};
__device__ __forceinline__ XcdBarrier xcd_barrier_post(unsigned* bar, volatile LAS unsigned* st) {
    XcdBarrier b; b.bar = bar; b.x = xb_xcc_id(); b.st = st;
    if (threadIdx.x == 0) (void)xb_add(&bar[XB_XCNT(b.x)], 1u);
    return b;
}
__device__ __forceinline__ void xcd_barrier_complete(unsigned* bar, unsigned x, unsigned& nloc, unsigned& nx) {
    const unsigned G = gridDim.x * gridDim.y * gridDim.z;
    unsigned sum, cnt, mine, sp = 0u;
    for (;;) {
        sum = 0u; cnt = 0u; mine = 0u;
#pragma unroll
        for (unsigned j = 0; j < 16; ++j) { const unsigned c = xb_ld(&bar[XB_XCNT(j)]); sum += c; cnt += (c > 0u) ? 1u : 0u; mine = (j == x) ? c : mine; }
        if (sum == G) break;
        __builtin_amdgcn_s_sleep(1);
        if ((++sp & 255u) == 0u) { if (xb_ld(&bar[XB_TMO])) break; if (sp > XB_SPIN_CAP) { atomicAdd(&bar[XB_TMO], 1u); break; } }
    }
    nloc = mine > 0u ? mine : 1u; nx = cnt > 0u ? cnt : 1u;
}
__device__ __forceinline__ void xcd_barrier(const XcdBarrier& b, bool leader) {
    asm volatile("s_waitcnt vmcnt(0)" ::: "memory");
    __syncthreads();
    if (leader) {
        unsigned* bar = b.bar;
        __builtin_amdgcn_s_waitcnt(0);
        unsigned nloc = b.st[0], nx = b.st[1];
        const unsigned old = xb_add(&bar[XB_XSUB(b.x)], 1u);
        const unsigned gen = old / nloc;
        if (old + 1u == (gen + 1u) * nloc) {
            __builtin_amdgcn_fence(__ATOMIC_RELEASE, "agent");
            asm volatile("s_waitcnt vmcnt(0)" ::: "memory");
            const unsigned og = xb_add(&bar[XB_TOP], 1u);
            const unsigned tg = og / nx;
            if (og + 1u == (tg + 1u) * nx) xb_add(&bar[XB_TOPGEN], 1u);
            else XB_SPIN(xb_ld(&bar[XB_TOPGEN]) == tg, bar);
            __builtin_amdgcn_fence(__ATOMIC_ACQUIRE, "agent");
            xb_add(&bar[XB_XGEN(b.x)], 1u);
            asm volatile("s_waitcnt vmcnt(0)" ::: "memory");
        } else {
            XB_SPIN(xb_ld(&bar[XB_XGEN(b.x)]) == gen, bar);
            __builtin_amdgcn_fence(__ATOMIC_ACQUIRE, "agent");
            asm volatile("s_waitcnt vmcnt(0)" ::: "memory");
        }
    }
    __syncthreads();
}

struct Args {
    const float* in[19];
    float* out;
    unsigned char* ws;
    int ph_lo, ph_hi;
};
typedef const Args __attribute__((address_space(4))) KArgs;
struct Frame {
    LAS unsigned char* lds;
    unsigned char* ws; float* out;
    int tid, lane, wave, G, gw, NGW;
};

constexpr int CW_DQ = 8192;
constexpr int DQ_LDS = LDSCTL_OFF;
#define DYN_LOOP_BEGIN(u, NU, qid) { unsigned* dq_ctr_ = (unsigned*)(F.ws + WS_CTL) + CW_DQ + 64 * (qid); volatile LAS int* dq_l_ = (volatile LAS int*)(F.lds + DQ_LDS); \
    __syncthreads(); if (F.tid == 0) *dq_l_ = (int)__hip_atomic_fetch_add(dq_ctr_, 1u, __ATOMIC_RELAXED, __HIP_MEMORY_SCOPE_AGENT); __syncthreads(); int u = *dq_l_; \
    while (u < (NU)) { int dq_n_ = 0; if (F.tid == 0) dq_n_ = (int)__hip_atomic_fetch_add(dq_ctr_, 1u, __ATOMIC_RELAXED, __HIP_MEMORY_SCOPE_AGENT);
#define DYN_LOOP_END(u) __syncthreads(); if (F.tid == 0) *dq_l_ = dq_n_; __syncthreads(); u = *dq_l_; } }

__device__ __forceinline__ void transpose_item(const float* W, int K, int Nsrc, const float* kscale, bf16* WT, int k0, int ns0, int nd0, LAS float* scr, int lane) {
    if (ns0 >= 0) {
        float v[32];
#pragma unroll
        for (int i = 0; i < 32; ++i) { const int kk = 2 * i + (lane >> 5); v[i] = W[(size_t)(k0 + kk) * Nsrc + ns0 + (lane & 31)]; }
        if (kscale) {
#pragma unroll
            for (int i = 0; i < 32; ++i) { const int kk = 2 * i + (lane >> 5); v[i] *= kscale[k0 + kk]; } }
#pragma unroll
        for (int i = 0; i < 32; ++i) { const int kk = 2 * i + (lane >> 5); scr[kk * 33 + (lane & 31)] = v[i]; }
    } else {
#pragma unroll 8
        for (int i = 0; i < 32; ++i) { const int kk = 2 * i + (lane >> 5); scr[kk * 33 + (lane & 31)] = 0.f; }
    }
    LDS_WAIT(); asm volatile("" ::: "memory");
    const int c = lane & 7;
#pragma unroll
    for (int j = 0; j < 4; ++j) { const int n = (lane >> 3) + 8 * j; const LAS float* s = scr + (8 * c) * 33 + n;
        v4u o; o.x = pk2(s[0 * 33], s[1 * 33]); o.y = pk2(s[2 * 33], s[3 * 33]); o.z = pk2(s[4 * 33], s[5 * 33]); o.w = pk2(s[6 * 33], s[7 * 33]);
        *(v4u*)(WT + (size_t)(nd0 + n) * K + k0 + 8 * c) = o; }
    LDS_WAIT(); asm volatile("" ::: "memory");
}

constexpr int I_IN = (D / 64) * (IN_N / 32), I_OUT = (D / 64) * (D / 32), I_UP = (D / 64) * (FF / 32), I_DN = (FF / 64) * (D / 32);
__device__ __forceinline__ void convert_item(const Frame& F, KArgs& a, int m, int layer, int r, LAS float* scr, int lane) {
    unsigned char* ws = F.ws;
    if (m == 0) { const int nblk = IN_N / 32, kb = r / nblk, nb = r % nblk, nd0 = nb * 32;
        const int ns0 = nd0 < 2560 ? nd0 : (nd0 < 10240 ? nd0 + 32 : (nd0 < 10272 ? 2560 : -1));
        transpose_item(a.in[4] + (size_t)layer * D * IN_SRC, D, IN_SRC, a.in[3] + layer * D, (bf16*)(ws + WS_WIN + layer * SZ_WIN), kb * 64, ns0, nd0, scr, lane); }
    else if (m == 1) { const int nblk = D / 32, kb = r / nblk, nb = r % nblk;
        transpose_item(a.in[14] + (size_t)layer * D * D, D, D, nullptr, (bf16*)(ws + WS_WOUT + layer * SZ_WOUT), kb * 64, nb * 32, nb * 32, scr, lane); }
    else if (m == 2) { const int nblk = FF / 32, kb = r / nblk, nb = r % nblk;
        transpose_item(a.in[16] + (size_t)layer * D * FF, D, FF, a.in[15] + layer * D, (bf16*)(ws + WS_WUP + layer * SZ_WUP), kb * 64, nb * 32, nb * 32, scr, lane); }
    else { const int nblk = D / 32, kb = r / nblk, nb = r % nblk;
        transpose_item(a.in[17] + (size_t)layer * FF * D, FF, D, nullptr, (bf16*)(ws + WS_WDN + layer * SZ_WDN), kb * 64, nb * 32, nb * 32, scr, lane); }
}
__device__ __forceinline__ int bg_entries(int list, int layer) { return list == 0 ? I_UP / 64 : (list == 1 ? I_OUT / 64 : (layer == 0 ? (I_DN + I_IN) / 64 : I_DN / 64)); }
__device__ __forceinline__ void bg_entry(const Frame& F, KArgs& a, int list, int layer, int e) {
    __syncthreads();
    LAS float* scr = (LAS float*)(F.lds + RING_OFF + F.wave * 16384);
    const int ln = opaque_lane();
#pragma unroll 1
    for (int j = 0; j < 8; ++j) { const int r = e * 64 + F.wave * 8 + j;
        if (list == 0) convert_item(F, a, 2, layer, r, scr, ln);
        else if (list == 1) convert_item(F, a, 1, layer, r, scr, ln);
        else { if (r < I_DN) convert_item(F, a, 3, layer, r, scr, ln); else convert_item(F, a, 0, layer + 1, r - I_DN, scr, ln); } }
}
__device__ __forceinline__ int bg_split(int q, int NU, int NB, int& unit) { const int T = NU + NB, b0 = (q * NB) / T, b1 = ((q + 1) * NB) / T; unit = q - b0; return b1 > b0 ? b0 : -1; }

__device__ __forceinline__ void p_prologue(const Frame& F, KArgs& a) {
    LAS float* scr = (LAS float*)(F.lds + RING_OFF + F.wave * 16384);
    unsigned char* ws = F.ws;
    for (int it = F.gw; it < I_IN; it += F.NGW) convert_item(F, a, 0, 0, it, scr, F.lane);
    float* hm = (float*)(ws + WS_HM);
    bf16* XN = (bf16*)(ws + WS_HB);
    float* rs0 = (float*)(ws + WS_RSTD);
    for (int row = F.gw; row < MP; row += F.NGW) {
        v2u* o = (v2u*)(XN + (size_t)row * D);
        if (row >= NTOK) {
            float* dst = hm + (size_t)(row - NREAL) * D;
            v2u* xm = (v2u*)((bf16*)(ws + WS_XN) + (size_t)row * D);
#pragma unroll
            for (int j = 0; j < 16; ++j) { ((f32x4*)dst)[F.lane + 64 * j] = (f32x4){0.f, 0.f, 0.f, 0.f}; o[F.lane + 64 * j] = (v2u){0u, 0u}; xm[F.lane + 64 * j] = (v2u){0u, 0u}; }
            if (F.lane == 0) rs0[row] = 0.f;
            continue; }
        const f32x4* src; float* dst;
        if (row < NREAL) { src = (const f32x4*)((row < 8192 ? a.in[0] + (size_t)row * D : a.in[1] + (size_t)(row - 8192) * D)); dst = nullptr; }
        else { src = (const f32x4*)(a.in[2] + (size_t)((row - NREAL) & 15) * D); dst = hm + (size_t)(row - NREAL) * D; }
        float sq = 0.f;
#pragma unroll
        for (int j = 0; j < 16; ++j) { const f32x4 v = src[F.lane + 64 * j];
            if (dst) ((f32x4*)dst)[F.lane + 64 * j] = v;
            o[F.lane + 64 * j] = (v2u){pk2(v.x, v.y), pk2(v.z, v.w)}; sq += (v.x * v.x + v.y * v.y) + (v.z * v.z + v.w * v.w); }
        sq = wave_sum(sq);
        if (F.lane == 0) rs0[row] = rsqrtf(sq * (1.f / D) + EPS);
    }
}

__device__ __forceinline__ void p_norm_meta(const Frame& F, int k) {
    float* hm = (float*)(F.ws + WS_HM);
    const float* slab = (const float*)(F.ws + WS_SLAB);
    bf16* XN = (bf16*)(F.ws + WS_HB);
    float* rs = (float*)(F.ws + WS_RSTD) + (size_t)k * MP;
    const float* ssp = (const float*)(F.ws + WS_SSP);
    for (int row = F.gw * 4; row < NREAL; row += F.NGW * 4) {
        float t[4];
#pragma unroll
        for (int j = 0; j < 4; ++j) t[j] = ssp[(size_t)(row + j) * 64 + F.lane];
#pragma unroll
        for (int j = 0; j < 4; ++j) t[j] = wave_sum(t[j]);
        if (F.lane == 0) {
#pragma unroll
            for (int j = 0; j < 4; ++j) rs[row + j] = rsqrtf(t[j] * (1.f / D) + EPS); } }
    for (int mr = F.gw; mr < 256; mr += F.NGW) {
        const int row = NREAL + mr;
        v2u* o = (v2u*)(XN + (size_t)row * D);
        if (F.lane == 0) rs[row] = 1.f;
        if (mr >= NSEQ * NMETA) {
#pragma unroll
            for (int j = 0; j < 16; ++j) o[F.lane + 64 * j] = (v2u){0u, 0u};
            continue; }
        f32x4* src = (f32x4*)(hm + (size_t)mr * D);
        f32x4 v[16]; float sq = 0.f;
#pragma unroll
        for (int j = 0; j < 16; ++j) v[j] = src[F.lane + 64 * j];
#pragma unroll 1
        for (int ks = 0; ks < 16; ++ks) { const f32x4* sp = (const f32x4*)(slab + ((size_t)ks * 256 + mr) * D);
#pragma unroll
            for (int j = 0; j < 16; ++j) v[j] = v[j] + sp[F.lane + 64 * j]; }
#pragma unroll
        for (int j = 0; j < 16; ++j) { src[F.lane + 64 * j] = v[j]; sq += (v[j].x * v[j].x + v[j].y * v[j].y) + (v[j].z * v[j].z + v[j].w * v[j].w); }
        const float rstd = rsqrtf(wave_sum(sq) * (1.f / D) + EPS);
#pragma unroll
        for (int j = 0; j < 16; ++j) o[F.lane + 64 * j] = (v2u){pk2(v[j].x * rstd, v[j].y * rstd), pk2(v[j].z * rstd, v[j].w * rstd)};
    }
}
__device__ __forceinline__ void p_final_norm(const Frame& F, KArgs& a) {
    const f32x4* w = (const f32x4*)a.in[18];
    const float* ssp = (const float*)(F.ws + WS_SSP);
    const bf16* HB = (const bf16*)(F.ws + WS_HB);
    for (int row0 = F.gw * 2; row0 < NREAL; row0 += F.NGW * 2) {
        v2u hv[2][16]; float sp[2];
#pragma unroll
        for (int q = 0; q < 2; ++q) { const v2u* hsrc = (const v2u*)(HB + (size_t)(row0 + q) * D); sp[q] = ssp[(size_t)(row0 + q) * 64 + F.lane];
#pragma unroll
            for (int j = 0; j < 16; ++j) hv[q][j] = hsrc[F.lane + 64 * j]; }
#pragma unroll
        for (int q = 0; q < 2; ++q) { f32x4* p = (f32x4*)(F.out + (size_t)(row0 + q) * D);
            const float rstd = rsqrtf(wave_sum(sp[q]) * (1.f / D) + EPS);
#pragma unroll
            for (int j = 0; j < 16; ++j) { const f32x4 v = (f32x4){bflo(hv[q][j].x), bfhi(hv[q][j].x), bflo(hv[q][j].y), bfhi(hv[q][j].y)}; p[F.lane + 64 * j] = v * rstd * w[F.lane + 64 * j]; } }
    }
}

__device__ __forceinline__ void p_ssd_prep(const Frame& F, KArgs& a, int layer) {
    const bf16* P = (const bf16*)(F.ws + WS_P);
    const float* DT = (const float*)(F.ws + WS_DT);
    float* DTL = (float*)(F.ws + WS_DTL);
    bf16* XBC = (bf16*)(F.ws + WS_XBC);
    const float* cw = a.in[5] + (size_t)layer * 5 * 1536;
    const float* cb = a.in[6] + (size_t)layer * 1536;
    const int NW3 = F.NGW / 3;
    if (F.gw >= 3 * NW3) return;
    const int cc = F.gw % 3, k0 = F.gw / 3;
    const int c0 = cc * 512 + F.lane * 8;
    float wgt[5][8], bias[8];
#pragma unroll
    for (int i = 0; i < 8; ++i) bias[i] = cb[c0 + i];
#pragma unroll
    for (int j = 0; j < 5; ++j)
#pragma unroll
        for (int i = 0; i < 8; ++i) wgt[j][i] = cw[j * 1536 + c0 + i];
    const int dl = F.lane & 31, dp = F.lane >> 5;
    const float dtb = a.in[7][layer * 32 + dl], aexp = __expf(a.in[8][layer * 32 + dl]);
    constexpr int RL = 16, NROW = RL + 4, RUNS_P = 257, RUNS_S = 129;
    constexpr int NRUN = 2 * RUNS_P + 8 * RUNS_S;
#pragma unroll 1
    for (int run = k0; run < NRUN; run += NW3) {
        int s, l0;
        if (run < 2 * RUNS_P) { s = run / RUNS_P; l0 = (run - s * RUNS_P) * RL; } else { const int q = run - 2 * RUNS_P; s = 2 + q / RUNS_S; l0 = (q - (s - 2) * RUNS_S) * RL; }
        const int L = seq_T(s) + NMETA;
        v4u rw[NROW];
#pragma unroll
        for (int j = 0; j < NROW; ++j) { const int lj = l0 - 2 + j; const bool ok = lj >= 0 && lj < L;
            rw[j] = ok ? *(const v4u*)(P + (size_t)row_of(s, lj) * P_LD + PC_XBC + c0) : (v4u){0u, 0u, 0u, 0u}; }
        float dtv[RL / 2];
        if (cc == 0) {
#pragma unroll
            for (int t2 = 0; t2 < RL / 2; ++t2) { const int l = l0 + 2 * t2 + dp; dtv[t2] = l < L ? DT[(size_t)row_of(s, l) * 32 + dl] : 0.f; }
        }
        float acc[RL][8];
#pragma unroll
        for (int t = 0; t < RL; ++t)
#pragma unroll
            for (int i = 0; i < 8; ++i) acc[t][i] = bias[i];
#pragma unroll
        for (int j = 0; j < NROW; ++j) {
            float x[8]; unpack8(rw[j], x);
#pragma unroll
            for (int jj = 0; jj < 5; ++jj) { const int t = j - jj; if (t < 0 || t >= RL) continue;
#pragma unroll
                for (int i = 0; i < 8; ++i) acc[t][i] += wgt[jj][i] * x[i]; }
            const int td = j - 4;
            if (td >= 0) { const int l = l0 + td;
                if (l < L) { v4u o; o.x = pk2(siluf(acc[td][0]), siluf(acc[td][1])); o.y = pk2(siluf(acc[td][2]), siluf(acc[td][3])); o.z = pk2(siluf(acc[td][4]), siluf(acc[td][5])); o.w = pk2(siluf(acc[td][6]), siluf(acc[td][7]));
                    *(v4u*)(XBC + (size_t)row_of(s, l) * 1536 + c0) = o; } }
        }
        if (cc == 0) {
#pragma unroll
            for (int t2 = 0; t2 < RL / 2; ++t2) { const int l = l0 + 2 * t2 + dp;
                if (l < L) { const int row = row_of(s, l); const float x = dtv[t2] + dtb; const float sp = x > 20.f ? x : log1pf(__expf(x));
                    DTL[(size_t)row * 64 + dl] = sp; DTL[(size_t)row * 64 + 32 + dl] = -sp * aexp; } }
        }
    }
}

typedef short s16x4 __attribute__((ext_vector_type(4)));
typedef short v4i16_t __attribute__((ext_vector_type(4)));
constexpr int NCHUNK = 202;
__device__ __forceinline__ void chunk_decode(int cid, int& s, int& c) { if (cid < 66) { s = cid / 33; c = cid - s * 33; } else { const int q = cid - 66; const int s2 = q / 17; s = 2 + s2; c = q - s2 * 17; } }
__device__ __forceinline__ int chunk_row(int s, int c, int t) { return c == 0 ? (t < 112 ? -1 : META0 + s * NMETA + t - 112) : seq_start(s) + (c - 1) * 128 + t; }
__device__ __forceinline__ s16x4 lds_tr(const LAS unsigned char* p) { return __builtin_bit_cast(s16x4, __builtin_amdgcn_ds_read_tr16_b64_v4i16((LAS v4i16_t*)p)); }
__device__ __forceinline__ bf16x8 cat4(s16x4 a, s16x4 b) { return (bf16x8){a[0], a[1], a[2], a[3], b[0], b[1], b[2], b[3]}; }
__device__ __forceinline__ f32x4 mfma16(bf16x8 a, bf16x8 b, f32x4 c) { return __builtin_amdgcn_mfma_f32_16x16x32_bf16(a, b, c, 0, 0, 0); }
__device__ __forceinline__ bf16x8 pack8(const float (&f)[8]) { v4u w; w.x = pk2(f[0], f[1]); w.y = pk2(f[2], f[3]); w.z = pk2(f[4], f[5]); w.w = pk2(f[6], f[7]); return __builtin_bit_cast(bf16x8, w); }

constexpr int XPITCH = 144;
constexpr int SA_BIMG = 0, SA_XP = 73728, SA_DEC = 110592;
constexpr int SC_CIMG = 0, SC_BIMG = 36864, SC_XP = 73728, SC_DEC = 110592, SC_XCH = 126976;
static_assert(SC_XCH + 4096 <= RING_BYTES, "scan LDS map");

constexpr int NHS = 24;

__device__ __forceinline__ float wave_incl_scan(float v, int lane) {
#pragma unroll
    for (int o = 1; o < 64; o <<= 1) { const float u = __shfl_up(v, o); if (lane >= o) v += u; }
    return v;
}
constexpr float LOG2E_G = 1.4426950408889634f;
__device__ __forceinline__ void decay_setup(LAS float* dec, float laf0, float laf1, float lab0, float lab1, float dtf0, float dtf1, float dtb0, float dtb1, int lane, float& cfe, float& cbe) {
    laf0 *= LOG2E_G; laf1 *= LOG2E_G; lab0 *= LOG2E_G; lab1 *= LOG2E_G;
    float f0 = wave_incl_scan(laf0, lane), f1 = wave_incl_scan(laf1, lane);
    const float ft = __shfl(f0, 63); f1 += ft;
    float b0 = wave_incl_scan(lab0, lane), b1 = wave_incl_scan(lab1, lane);
    const float bt = __shfl(b0, 63); b1 += bt;
    cfe = __shfl(f1, 63); cbe = __shfl(b1, 63);
    dec[lane] = f0; dec[64 + lane] = f1;
    dec[128 + lane] = b0 - lab0; dec[192 + lane] = b1 - lab1;
    dec[256 + lane] = __log2f(dtf0) - f0; dec[320 + lane] = __log2f(dtf1) - f1;
    dec[384 + lane] = (b0 - lab0) + __log2f(dtb0); dec[448 + lane] = (b1 - lab1) + __log2f(dtb1);
    LDS_WAIT();
}
struct DecRaw { float laf0, laf1, lab0, lab1, dtf0, dtf1, dtb0, dtb1; };
template <bool SSD>
__device__ __forceinline__ DecRaw decay_raw(const Frame& F, KArgs& a, int layer, int s, int c, int h, int lane) {
    const int r0 = chunk_row(s, c, lane), r1 = chunk_row(s, c, 64 + lane);
    DecRaw d{0.f, 0.f, 0.f, 0.f, 0.f, 0.f, 0.f, 0.f};
    if (SSD) {
        const float* DTL = (const float*)(F.ws + WS_DTL);
        if (r0 >= 0) { const float* p = DTL + (size_t)r0 * 64; d.dtf0 = p[h]; d.dtb0 = p[16 + h]; d.laf0 = p[32 + h]; d.lab0 = p[48 + h]; }
        if (r1 >= 0) { const float* p = DTL + (size_t)r1 * 64; d.dtf1 = p[h]; d.dtb1 = p[16 + h]; d.laf1 = p[32 + h]; d.lab1 = p[48 + h]; }
    } else {
        const float x0 = a.in[13][layer * 16 + h], x1 = a.in[13][layer * 16 + 8 + h];
        const float lgf = fminf(x0, 0.f) - log1pf(__expf(-fabsf(x0))), lgb = fminf(x1, 0.f) - log1pf(__expf(-fabsf(x1)));
        if (r0 >= 0) { d.laf0 = lgf; d.lab0 = lgb; d.dtf0 = 0.125f; d.dtb0 = 0.125f; }
        if (r1 >= 0) { d.laf1 = lgf; d.lab1 = lgb; d.dtf1 = 0.125f; d.dtb1 = 0.125f; }
    }
    return d;
}
template <bool SSD>
__device__ __forceinline__ void decay_load(const Frame& F, KArgs& a, int layer, int s, int c, int h, int lane, LAS float* dec, float& cfe, float& cbe) {
    const DecRaw d = decay_raw<SSD>(F, a, layer, s, c, h, lane);
    decay_setup(dec, d.laf0, d.laf1, d.lab0, d.lab1, d.dtf0, d.dtf1, d.dtb0, d.dtb1, lane, cfe, cbe);
}
template <int NROWS, int PPR>
__device__ __forceinline__ void stage_rows_ld(v4u (&v)[NROWS * PPR / NTHREADS], const bf16* src, int ld, int col0, int s, int c, int t0, int tid) {
    static_assert((NROWS * PPR) % NTHREADS == 0, "stage_rows");
#pragma unroll
    for (int q = 0; q < NROWS * PPR / NTHREADS; ++q) { const int idx = tid + q * NTHREADS, r = idx / PPR, pc = idx % PPR; const int row = chunk_row(s, c, t0 + r);
        v[q] = row >= 0 ? *(const v4u*)(src + (size_t)row * ld + col0 + pc * 8) : (v4u){0u, 0u, 0u, 0u}; }
}
template <int NROWS, int PPR>
__device__ __forceinline__ void stage_rows_st(const v4u (&v)[NROWS * PPR / NTHREADS], LAS unsigned char* dst, int pitchB, int tid) {
#pragma unroll
    for (int q = 0; q < NROWS * PPR / NTHREADS; ++q) { const int idx = tid + q * NTHREADS, r = idx / PPR, pc = idx % PPR; *(LAS v4u*)(dst + r * pitchB + pc * 16) = v[q]; }
}
template <int NROWS, int PPR>
__device__ __forceinline__ void stage_rows(LAS unsigned char* dst, int pitchB, const bf16* src, int ld, int col0, int s, int c, int t0, int tid) {
    v4u v[NROWS * PPR / NTHREADS]; stage_rows_ld<NROWS, PPR>(v, src, ld, col0, s, c, t0, tid); stage_rows_st<NROWS, PPR>(v, dst, pitchB, tid);
}
__device__ __forceinline__ void xblock_load(v4u (&xr)[4], const bf16* src, int ld, int col0, int s, int c, int sb, int lane) {
#pragma unroll
    for (int q = 0; q < 4; ++q) { const int idx = lane + 64 * q, r = idx >> 3, pc = idx & 7; const int row = chunk_row(s, c, sb * 32 + r);
        xr[q] = row >= 0 ? *(const v4u*)(src + (size_t)row * ld + col0 + pc * 8) : (v4u){0u, 0u, 0u, 0u}; }
}
__device__ __forceinline__ void xblock_store(const v4u (&xr)[4], LAS unsigned char* xp, int lane) {
#pragma unroll
    for (int q = 0; q < 4; ++q) { const int idx = lane + 64 * q, r = idx >> 3, pc = idx & 7; *(LAS v4u*)(xp + r * XPITCH + pc * 16) = xr[q]; }
}

template <int NK>
__device__ __forceinline__ void scanA_job(const LAS unsigned char* bimg, LAS unsigned char* xp, const LAS float* dec, float cfe,
                                          const bf16* xsrc, int xld, int xcol0, int s, int c, bf16* locf, bf16* locb, int lane, const v4u (&xr0)[4]) {
    constexpr int NKP2 = (NK + 8) * 2, NPASS = NK / 64;
    const int g = lane >> 4, i = lane & 15;
#pragma unroll 1
    for (int np = 0; np < NPASS; ++np) {
        f32x4 Lf[4][4], Lb[4][4];
#pragma unroll
        for (int pt = 0; pt < 4; ++pt)
#pragma unroll
            for (int nt = 0; nt < 4; ++nt) { Lf[pt][nt] = (f32x4){0.f, 0.f, 0.f, 0.f}; Lb[pt][nt] = (f32x4){0.f, 0.f, 0.f, 0.f}; }
        v4u xr[4];
        if (np == 0) {
#pragma unroll
            for (int q = 0; q < 4; ++q) xr[q] = xr0[q]; } else xblock_load(xr, xsrc, xld, xcol0, s, c, 0, lane);
#pragma unroll 1
        for (int sb = 0; sb < 4; ++sb) {
            xblock_store(xr, xp, lane);
            if (sb < 3) xblock_load(xr, xsrc, xld, xcol0, s, c, sb + 1, lane);
            float wf[8], wb[8];
            { const LAS float* d = dec + sb * 32 + 8 * g;
              const f32x4 a0 = *(const LAS f32x4*)(d + 256), a1 = *(const LAS f32x4*)(d + 260), b0 = *(const LAS f32x4*)(d + 384), b1 = *(const LAS f32x4*)(d + 388);
#pragma unroll
              for (int j = 0; j < 4; ++j) { wf[j] = __builtin_amdgcn_exp2f(cfe + a0[j]); wf[4 + j] = __builtin_amdgcn_exp2f(cfe + a1[j]); wb[j] = __builtin_amdgcn_exp2f(b0[j]); wb[4 + j] = __builtin_amdgcn_exp2f(b1[j]); } }
            LDS_WAIT();
            bf16x8 xaf[4], xab[4];
#pragma unroll
            for (int pt = 0; pt < 4; ++pt) {
                const LAS unsigned char* ap = xp + (8 * g + (i >> 2)) * XPITCH + (16 * pt + 4 * (i & 3)) * 2;
                const bf16x8 raw = cat4(lds_tr(ap), lds_tr(ap + 4 * XPITCH));
                float x[8]; unpack8(__builtin_bit_cast(v4u, raw), x);
                float xf[8], xb[8];
#pragma unroll
                for (int j = 0; j < 8; ++j) { xf[j] = x[j] * wf[j]; xb[j] = x[j] * wb[j]; }
                xaf[pt] = pack8(xf); xab[pt] = pack8(xb);
            }
#pragma unroll
            for (int nt = 0; nt < 4; ++nt) {
                const LAS unsigned char* bp = bimg + (sb * 32 + 8 * g + (i >> 2)) * NKP2 + (np * 64 + 16 * nt + 4 * (i & 3)) * 2;
                const bf16x8 bb = cat4(lds_tr(bp), lds_tr(bp + 4 * NKP2));
#pragma unroll
                for (int pt = 0; pt < 4; ++pt) { Lf[pt][nt] = mfma16(xaf[pt], bb, Lf[pt][nt]); Lb[pt][nt] = mfma16(xab[pt], bb, Lb[pt][nt]); }
            }
        }
        { int lz = lane; asm volatile("" : "+v"(lz));
          const int ob = (4 * (lz >> 4)) * NK + np * 64 + (lz & 15);
#pragma unroll
          for (int pt = 0; pt < 4; ++pt)
#pragma unroll
            for (int nt = 0; nt < 4; ++nt)
#pragma unroll
                for (int r = 0; r < 4; ++r) { const int o = ob + (16 * pt + r) * NK + 16 * nt; locf[o] = (bf16)f2bf(Lf[pt][nt][r]); locb[o] = (bf16)f2bf(Lb[pt][nt][r]); } }
    }
}

__device__ __forceinline__ void p_scanA(const Frame& F, KArgs& a, int layer) {
    const bf16* P = (const bf16*)(F.ws + WS_P);
    const bf16* XBC = (const bf16*)(F.ws + WS_XBC);
    bf16* LOC = (bf16*)(F.ws + WS_LOC);
    float* CDEC = (float*)(F.ws + WS_CDEC);
    LAS unsigned char* xp = F.lds + SA_XP + F.wave * 4608;
    LAS float* dec = (LAS float*)(F.lds + SA_DEC + F.wave * 2048);
    const int NBG = bg_entries(1, layer);
    DYN_LOOP_BEGIN(q, 808 + NBG, layer * 4 + 1)
        int u; const int be = bg_split(q, 808, NBG, u);
        if (be >= 0) { bg_entry(F, a, 1, layer, be); } else {
        const bool ssd = u < 404; const int uu = ssd ? u : u - 404; const int cid = uu >> 1, sub = uu & 1;
        int s, c; chunk_decode(cid, s, c);
        __syncthreads();
        float cfe, cbe;
        int tz = F.tid; asm volatile("" : "+v"(tz));
        if (ssd) {
            const int h = sub * 8 + F.wave;
            v4u sb_[4]; stage_rows_ld<128, 16>(sb_, XBC, 1536, 1024 + sub * 128, s, c, 0, tz);
            const DecRaw dr = decay_raw<true>(F, a, layer, s, c, h, tz & 63);
            v4u xr0[4]; xblock_load(xr0, XBC, 1536, h * 64, s, c, 0, tz & 63);
            stage_rows_st<128, 16>(sb_, F.lds + SA_BIMG, 272, tz);
            decay_setup(dec, dr.laf0, dr.laf1, dr.lab0, dr.lab1, dr.dtf0, dr.dtf1, dr.dtb0, dr.dtb1, tz & 63, cfe, cbe);
            __syncthreads();
            bf16* lf = LOC + ((size_t)(cid * NHS + h) * 2) * 8192;
            int lz = F.lane; asm volatile("" : "+v"(lz));
            scanA_job<128>(F.lds + SA_BIMG, xp, dec, cfe, XBC, 1536, h * 64, s, c, lf, lf + 8192, lz, xr0);
            if (F.lane == 0) { CDEC[(cid * NHS + h) * 2] = __builtin_amdgcn_exp2f(cfe); CDEC[(cid * NHS + h) * 2 + 1] = __builtin_amdgcn_exp2f(cbe); }
        } else {
            const int hd = F.wave >> 1, vh = F.wave & 1, h = sub * 4 + hd;
            v4u sk_[4][2];
#pragma unroll
            for (int k = 0; k < 4; ++k) stage_rows_ld<128, 8>(sk_[k], P, P_LD, PC_RET + 512 + (sub * 4 + k) * 64, s, c, 0, tz);
            const DecRaw dr = decay_raw<false>(F, a, layer, s, c, h, tz & 63);
            v4u xr0[4]; xblock_load(xr0, P, P_LD, PC_RET + 1024 + h * 128 + vh * 64, s, c, 0, tz & 63);
#pragma unroll
            for (int k = 0; k < 4; ++k) stage_rows_st<128, 8>(sk_[k], F.lds + SA_BIMG + k * 18432, 144, tz);
            decay_setup(dec, dr.laf0, dr.laf1, dr.lab0, dr.lab1, dr.dtf0, dr.dtf1, dr.dtb0, dr.dtb1, tz & 63, cfe, cbe);
            __syncthreads();
            bf16* lf = LOC + ((size_t)(cid * NHS + 16 + h) * 2) * 8192 + vh * 64 * 64;
            int lz = F.lane; asm volatile("" : "+v"(lz));
            scanA_job<64>(F.lds + SA_BIMG + hd * 18432, xp, dec, cfe, P, P_LD, PC_RET + 1024 + h * 128 + vh * 64, s, c, lf, lf + 8192, lz, xr0);
            if (F.lane == 0 && vh == 0) { CDEC[(cid * NHS + 16 + h) * 2] = __builtin_amdgcn_exp2f(cfe); CDEC[(cid * NHS + 16 + h) * 2 + 1] = __builtin_amdgcn_exp2f(cbe); }
        }
        }
    DYN_LOOP_END(q)
    __syncthreads();
}

__device__ __forceinline__ void p_scanB(const Frame& F, KArgs& a) {
    const bf16* LOC = (const bf16*)(F.ws + WS_LOC);
    const float* CDEC = (const float*)(F.ws + WS_CDEC);
    bf16* SIN = (bf16*)(F.ws + WS_SIN);
    for (int it = blockIdx.x; it < 960; it += F.G) {
        const int sl = it & 1, dir = (it >> 1) & 1, hs = (it >> 2) % NHS, s = (it >> 2) / NHS;
        const int nch = s < 2 ? 33 : 17, cb = s < 2 ? s * 33 : 66 + (s - 2) * 17;
        const int e = sl * 4096 + F.tid * 8;
        v4u lv[33]; float dv[33];
#pragma unroll
        for (int k = 0; k < 33; ++k) { const int kk = k < nch ? k : nch - 1; const int c = dir == 0 ? kk : nch - 1 - kk; const size_t o = ((size_t)((cb + c) * NHS + hs) * 2 + dir) * 8192 + e;
            lv[k] = *(const v4u*)(LOC + o); dv[k] = CDEC[((cb + c) * NHS + hs) * 2 + dir]; }
        float run[8];
#pragma unroll
        for (int j = 0; j < 8; ++j) run[j] = 0.f;
#pragma unroll
        for (int k = 0; k < 33; ++k) {
            if (k < nch) { const int c = dir == 0 ? k : nch - 1 - k; const size_t o = ((size_t)((cb + c) * NHS + hs) * 2 + dir) * 8192 + e;
                v4u w; w.x = pk2(run[0], run[1]); w.y = pk2(run[2], run[3]); w.z = pk2(run[4], run[5]); w.w = pk2(run[6], run[7]);
                *(v4u*)(SIN + o) = w;
                float l[8]; unpack8(lv[k], l);
#pragma unroll
                for (int j = 0; j < 8; ++j) run[j] = run[j] * dv[k] + l[j]; }
        }
    }
}

template <int NK>
__device__ __forceinline__ void scanC_job(f32x4 (&y)[4][4], const LAS unsigned char* cimg, const LAS unsigned char* bimg, LAS unsigned char* xp, const LAS float* dec, float cbe,
                                          const bf16* xsrc, int xld, int xcol0, int s, int c, int lbase, float dskip, const bf16* sinf, const bf16* sinb, int lane, const v4u (&xr0)[4]) {
    constexpr int NKP2 = (NK + 8) * 2, KS = NK / 32;
    const int g = lane >> 4, i = lane & 15;
#pragma unroll
    for (int lt = 0; lt < 4; ++lt)
#pragma unroll
        for (int pt = 0; pt < 4; ++pt) y[lt][pt] = (f32x4){0.f, 0.f, 0.f, 0.f};
    v4u xr[4];
#pragma unroll
    for (int q = 0; q < 4; ++q) xr[q] = xr0[q];
#pragma unroll 1
    for (int sb = 0; sb < 4; ++sb) {
        xblock_store(xr, xp, lane);
        if (sb < 3) xblock_load(xr, xsrc, xld, xcol0, s, c, sb + 1, lane);
        const LAS float* d = dec + sb * 32 + 4 * g;
        const f32x4 A0 = *(const LAS f32x4*)(d + 256), A1 = *(const LAS f32x4*)(d + 272), B0 = *(const LAS f32x4*)(d + 384), B1 = *(const LAS f32x4*)(d + 400);
        LDS_WAIT();
        bf16x8 xf[4];
#pragma unroll
        for (int pt = 0; pt < 4; ++pt) { const LAS unsigned char* ap = xp + (4 * g + (i >> 2)) * XPITCH + (16 * pt + 4 * (i & 3)) * 2; xf[pt] = cat4(lds_tr(ap), lds_tr(ap + 16 * XPITCH)); }
#pragma unroll
        for (int lt = 0; lt < 4; ++lt) {
            const int l = lbase + 16 * lt + i;
            const float cfl = dec[l], ebl = dec[128 + l];
            f32x4 t0 = (f32x4){0.f, 0.f, 0.f, 0.f}, t1 = (f32x4){0.f, 0.f, 0.f, 0.f};
#pragma unroll
            for (int kk = 0; kk < KS; ++kk) { const bf16x8 cf = *(const LAS bf16x8*)(cimg + (16 * lt + i) * NKP2 + (kk * 32 + 8 * g) * 2);
                const bf16x8 b0 = *(const LAS bf16x8*)(bimg + (sb * 32 + i) * NKP2 + (kk * 32 + 8 * g) * 2), b1 = *(const LAS bf16x8*)(bimg + (sb * 32 + 16 + i) * NKP2 + (kk * 32 + 8 * g) * 2);
                t0 = mfma16(b0, cf, t0); t1 = mfma16(b1, cf, t1); }
            float m[8];
            const int lt_lo = lbase + 16 * lt;
            if (sb * 32 + 31 < lt_lo) {
#pragma unroll
                for (int r = 0; r < 4; ++r) { m[r] = t0[r] * __builtin_amdgcn_exp2f(cfl + A0[r]); m[4 + r] = t1[r] * __builtin_amdgcn_exp2f(cfl + A1[r]); }
            } else if (sb * 32 > lt_lo + 15) {
#pragma unroll
                for (int r = 0; r < 4; ++r) { m[r] = t0[r] * __builtin_amdgcn_exp2f(B0[r] - ebl); m[4 + r] = t1[r] * __builtin_amdgcn_exp2f(B1[r] - ebl); }
            } else {
#pragma unroll
                for (int r = 0; r < 4; ++r) {
                    const int s0 = sb * 32 + 4 * g + r, s1 = s0 + 16;
                    m[r] = t0[r] * __builtin_amdgcn_exp2f(s0 <= l ? cfl + A0[r] : B0[r] - ebl) + (s0 == l ? dskip : 0.f);
                    m[4 + r] = t1[r] * __builtin_amdgcn_exp2f(s1 <= l ? cfl + A1[r] : B1[r] - ebl) + (s1 == l ? dskip : 0.f);
                }
            }
            const bf16x8 af = pack8(m);
#pragma unroll
            for (int pt = 0; pt < 4; ++pt) y[lt][pt] = mfma16(xf[pt], af, y[lt][pt]);
            __builtin_amdgcn_sched_barrier(0);
        }
    }
#pragma unroll 1
    for (int dir = 0; dir < 2; ++dir) {
        const bf16* S = dir == 0 ? sinf : sinb;
        bf16x8 sf[4][KS];
#pragma unroll
        for (int pt = 0; pt < 4; ++pt)
#pragma unroll
            for (int kk = 0; kk < KS; ++kk) sf[pt][kk] = *(const bf16x8*)(S + (size_t)(16 * pt + i) * NK + kk * 32 + 8 * g);
        float sc[4];
#pragma unroll
        for (int lt = 0; lt < 4; ++lt) { const int l = lbase + 16 * lt + i; sc[lt] = dir == 0 ? __builtin_amdgcn_exp2f(dec[l]) : __builtin_amdgcn_exp2f(cbe - dec[128 + l]); }
#pragma unroll
        for (int lt = 0; lt < 4; ++lt) {
            bf16x8 cf[KS];
#pragma unroll
            for (int kk = 0; kk < KS; ++kk) cf[kk] = *(const LAS bf16x8*)(cimg + (16 * lt + i) * NKP2 + (kk * 32 + 8 * g) * 2);
#pragma unroll
            for (int pt = 0; pt < 4; ++pt) {
                f32x4 t = (f32x4){0.f, 0.f, 0.f, 0.f};
#pragma unroll
                for (int kk = 0; kk < KS; ++kk) t = mfma16(sf[pt][kk], cf[kk], t);
                y[lt][pt] = y[lt][pt] + t * sc[lt];
            }
        }
    }
}

__device__ __forceinline__ void p_scanC(const Frame& F, KArgs& a, int layer) {
    const bf16* P = (const bf16*)(F.ws + WS_P);
    const bf16* XBC = (const bf16*)(F.ws + WS_XBC);
    const bf16* SIN = (const bf16*)(F.ws + WS_SIN);
    bf16* XN = (bf16*)(F.ws + WS_XN);
    LAS unsigned char* xp = F.lds + SC_XP + F.wave * 4608;
    LAS float* dec = (LAS float*)(F.lds + SC_DEC + F.wave * 2048);
    LAS float* xch = (LAS float*)(F.lds + SC_XCH);
    const int NBG = bg_entries(2, layer);
    DYN_LOOP_BEGIN(q, 1616 + NBG, layer * 4 + 2)
        int u; const int be = bg_split(q, 1616, NBG, u);
        if (be >= 0) { bg_entry(F, a, 2, layer, be); } else {
        const bool ssd = u < 808; const int uu = ssd ? u : u - 808; const int cid = uu >> 2, sub = uu & 3;
        int s, c; chunk_decode(cid, s, c);
        __syncthreads();
        float cfe, cbe; f32x4 y[4][4];
        int tz = F.tid; asm volatile("" : "+v"(tz));
        if (ssd) {
            const int grp = sub >> 1, lh = sub & 1, h = grp * 8 + F.wave;
            v4u sc_[2], sb_[4]; stage_rows_ld<64, 16>(sc_, XBC, 1536, 1280 + grp * 128, s, c, lh * 64, tz); stage_rows_ld<128, 16>(sb_, XBC, 1536, 1024 + grp * 128, s, c, 0, tz);
            const DecRaw dr = decay_raw<true>(F, a, layer, s, c, h, tz & 63);
            v4u xr0[4]; xblock_load(xr0, XBC, 1536, h * 64, s, c, 0, tz & 63);
            stage_rows_st<64, 16>(sc_, F.lds + SC_CIMG, 272, tz); stage_rows_st<128, 16>(sb_, F.lds + SC_BIMG, 272, tz);
            decay_setup(dec, dr.laf0, dr.laf1, dr.lab0, dr.lab1, dr.dtf0, dr.dtf1, dr.dtb0, dr.dtb1, tz & 63, cfe, cbe);
            __syncthreads();
            const bf16* sf = SIN + ((size_t)(cid * NHS + h) * 2) * 8192;
            int ly = F.lane; asm volatile("" : "+v"(ly));
            scanC_job<128>(y, F.lds + SC_CIMG, F.lds + SC_BIMG, xp, dec, cbe, XBC, 1536, h * 64, s, c, lh * 64, a.in[9][layer * 16 + h], sf, sf + 8192, ly, xr0);
            int lz = F.lane; asm volatile("" : "+v"(lz)); const int g = lz >> 4, i = lz & 15;
            v2u zz[4][4]; int rowl[4];
#pragma unroll
            for (int lt = 0; lt < 4; ++lt) { rowl[lt] = chunk_row(s, c, lh * 64 + 16 * lt + i);
#pragma unroll
                for (int pt = 0; pt < 4; ++pt) zz[lt][pt] = rowl[lt] >= 0 ? *(const v2u*)(P + (size_t)rowl[lt] * P_LD + PC_Z + h * 64 + 16 * pt + 4 * g) : (v2u){0u, 0u}; }
#pragma unroll
            for (int lt = 0; lt < 4; ++lt) { float acc = 0.f;
#pragma unroll
                for (int pt = 0; pt < 4; ++pt) { const f32x4 zf = (f32x4){bflo(zz[lt][pt].x), bfhi(zz[lt][pt].x), bflo(zz[lt][pt].y), bfhi(zz[lt][pt].y)};
#pragma unroll
                    for (int r = 0; r < 4; ++r) { const float v = y[lt][pt][r] * siluf(zf[r]); y[lt][pt][r] = v; acc += v * v; } }
                acc += __shfl_xor(acc, 16); acc += __shfl_xor(acc, 32);
                if (g == 0) xch[F.wave * 64 + 16 * lt + i] = acc; }
            __syncthreads();
            const float* nw = a.in[10] + layer * 1024 + h * 64;
#pragma unroll
            for (int lt = 0; lt < 4; ++lt) { float tot = 0.f;
#pragma unroll
                for (int w = 0; w < 8; ++w) tot += xch[w * 64 + 16 * lt + i];
                const float rstd = rsqrtf(tot * (1.f / 512.f) + EPS);
                if (rowl[lt] >= 0) {
#pragma unroll
                    for (int pt = 0; pt < 4; ++pt) { const f32x4 wv = *(const f32x4*)(nw + 16 * pt + 4 * g); const f32x4 o = y[lt][pt] * rstd * wv;
                        *(v2u*)(XN + (size_t)rowl[lt] * D + h * 64 + 16 * pt + 4 * g) = (v2u){pk2(o[0], o[1]), pk2(o[2], o[3])}; } } }
        } else {
            const int hd = F.wave >> 2, vh = (F.wave >> 1) & 1, lh = F.wave & 1, h = sub * 2 + hd;
            v4u sq_[2][2], sk_[2][2];
#pragma unroll
            for (int k = 0; k < 2; ++k) { stage_rows_ld<128, 8>(sq_[k], P, P_LD, PC_RET + (sub * 2 + k) * 64, s, c, 0, tz); stage_rows_ld<128, 8>(sk_[k], P, P_LD, PC_RET + 512 + (sub * 2 + k) * 64, s, c, 0, tz); }
            const DecRaw dr = decay_raw<false>(F, a, layer, s, c, h, tz & 63);
            v4u xr0[4]; xblock_load(xr0, P, P_LD, PC_RET + 1024 + h * 128 + vh * 64, s, c, 0, tz & 63);
#pragma unroll
            for (int k = 0; k < 2; ++k) { stage_rows_st<128, 8>(sq_[k], F.lds + SC_CIMG + k * 18432, 144, tz); stage_rows_st<128, 8>(sk_[k], F.lds + SC_BIMG + k * 18432, 144, tz); }
            decay_setup(dec, dr.laf0, dr.laf1, dr.lab0, dr.lab1, dr.dtf0, dr.dtf1, dr.dtb0, dr.dtb1, tz & 63, cfe, cbe);
            __syncthreads();
            const bf16* sf = SIN + ((size_t)(cid * NHS + 16 + h) * 2) * 8192 + vh * 64 * 64;
            int ly = F.lane; asm volatile("" : "+v"(ly));
            scanC_job<64>(y, F.lds + SC_CIMG + hd * 18432 + lh * 64 * 144, F.lds + SC_BIMG + hd * 18432, xp, dec, cbe, P, P_LD, PC_RET + 1024 + h * 128 + vh * 64, s, c, lh * 64, 0.f, sf, sf + 8192, ly, xr0);
            int lz = F.lane; asm volatile("" : "+v"(lz)); const int g = lz >> 4, i = lz & 15;
            v2u gz[4][4]; int rowl[4]; float sm[4], sq[4];
#pragma unroll
            for (int lt = 0; lt < 4; ++lt) { rowl[lt] = chunk_row(s, c, lh * 64 + 16 * lt + i);
#pragma unroll
                for (int pt = 0; pt < 4; ++pt) gz[lt][pt] = rowl[lt] >= 0 ? *(const v2u*)(P + (size_t)rowl[lt] * P_LD + PC_RET + 2048 + h * 128 + vh * 64 + 16 * pt + 4 * g) : (v2u){0u, 0u}; }
#pragma unroll
            for (int lt = 0; lt < 4; ++lt) { float a1 = 0.f, a2 = 0.f;
#pragma unroll
                for (int pt = 0; pt < 4; ++pt)
#pragma unroll
                    for (int r = 0; r < 4; ++r) { const float v = y[lt][pt][r]; a1 += v; a2 += v * v; }
                a1 += __shfl_xor(a1, 16); a1 += __shfl_xor(a1, 32); a2 += __shfl_xor(a2, 16); a2 += __shfl_xor(a2, 32); sm[lt] = a1; sq[lt] = a2;
                if (g == 0) { xch[(F.wave * 64 + 16 * lt + i) * 2] = a1; xch[(F.wave * 64 + 16 * lt + i) * 2 + 1] = a2; } }
            __syncthreads();
            const int pw = F.wave ^ 2;
#pragma unroll
            for (int lt = 0; lt < 4; ++lt) {
                const float t1 = sm[lt] + xch[(pw * 64 + 16 * lt + i) * 2], t2 = sq[lt] + xch[(pw * 64 + 16 * lt + i) * 2 + 1];
                const float mu = t1 * (1.f / 128.f), var = fmaxf(t2 * (1.f / 128.f) - mu * mu, 0.f), rstd = rsqrtf(var + 1e-5f);
                if (rowl[lt] >= 0) {
#pragma unroll
                    for (int pt = 0; pt < 4; ++pt) { const f32x4 gf = (f32x4){bflo(gz[lt][pt].x), bfhi(gz[lt][pt].x), bflo(gz[lt][pt].y), bfhi(gz[lt][pt].y)}; f32x4 o;
#pragma unroll
                        for (int r = 0; r < 4; ++r) o[r] = (y[lt][pt][r] - mu) * rstd * siluf(gf[r]);
                        *(v2u*)(XN + (size_t)rowl[lt] * D + 3072 + h * 128 + vh * 64 + 16 * pt + 4 * g) = (v2u){pk2(o[0], o[1]), pk2(o[2], o[3])}; } } }
        }
        }
    DYN_LOOP_END(q)
    __syncthreads();
}

constexpr int SW_KB = 0, SW_VB = 34816, SW_BLK = 17408;
__device__ __forceinline__ void swa_blk_load(v4u (&kv)[4], const bf16* P, int s, int kb, int nkb, int grp, int tid) {
#pragma unroll
    for (int q = 0; q < 4; ++q) { const int idx = tid + q * NTHREADS, isv = idx >> 10, r = (idx >> 4) & 63, pc = idx & 15;
        int row; if (kb >= 0) row = seq_start(s) + kb * 64 + r; else row = r < NMETA ? META0 + s * NMETA + r : -1;
        kv[q] = row >= 0 ? *(const v4u*)(P + (size_t)row * P_LD + PC_SWA + 1024 + isv * 256 + grp * 128 + pc * 8) : (v4u){0u, 0u, 0u, 0u}; }
}
__device__ __forceinline__ void swa_blk_store(const v4u (&kv)[4], LAS unsigned char* lds, int buf, int tid) {
#pragma unroll
    for (int q = 0; q < 4; ++q) { const int idx = tid + q * NTHREADS, isv = idx >> 10, r = (idx >> 4) & 63, pc = idx & 15;
        *(LAS v4u*)(lds + (isv ? SW_VB : SW_KB) + buf * SW_BLK + r * 272 + pc * 16) = kv[q]; }
}
__device__ __forceinline__ void swa_unit(const Frame& F, KArgs& a, int layer, int u) {
    const bf16* P = (const bf16*)(F.ws + WS_P);
    bf16* XN = (bf16*)(F.ws + WS_XN);
    constexpr float LOG2E = 1.4426950408889634f;
    {
        int s, qb, grp;
        if (u < 768) { const int ub = u >> 1; grp = u & 1; if (ub < 128) { s = ub >> 6; qb = ub & 63; } else { s = 2 + ((ub - 128) >> 5); qb = (ub - 128) & 31; } }
        else { s = (u - 768) >> 1; grp = u & 1; qb = -1; }
        const int T = seq_T(s), st0 = seq_start(s);
        const int kb_lo = qb < 0 ? 0 : (qb - 2 < 0 ? 0 : qb - 2), kb_hi = qb < 0 ? 1 : (qb + 2 > T / 64 - 1 ? T / 64 - 1 : qb + 2);
        const int nblk = kb_hi - kb_lo + 2;
        int tz = F.tid; asm volatile("" : "+v"(tz));
        const int lane = tz & 63, g = lane >> 4, i = lane & 15;
        const int hr = F.wave >> 1, half = F.wave & 1, hq = grp * 4 + hr;
        const int nq = qb < 0 ? NMETA : 64;
        bf16x8 qf[2][4]; int posq[2];
#pragma unroll
        for (int qt = 0; qt < 2; ++qt) { const int qi = half * 32 + 16 * qt + i; const bool ok = qi < nq; const int qc = ok ? qi : 0;
            const int row = qb < 0 ? META0 + s * NMETA + qc : st0 + qb * 64 + qc; posq[qt] = qb < 0 ? qc : NMETA + qb * 64 + qc;
#pragma unroll
            for (int kk = 0; kk < 4; ++kk) qf[qt][kk] = *(const bf16x8*)(P + (size_t)row * P_LD + PC_SWA + hq * 128 + kk * 32 + 8 * g); }
        const float slope2 = exp2f(-(float)(hq + 1)) * LOG2E, scale2 = 0.08838834764831845f * LOG2E;
        f32x4 O[2][8]; float lp[2] = {0.f, 0.f};
#pragma unroll
        for (int qt = 0; qt < 2; ++qt)
#pragma unroll
            for (int dt = 0; dt < 8; ++dt) O[qt][dt] = (f32x4){0.f, 0.f, 0.f, 0.f};
        v4u kv[2][4];
        swa_blk_load(kv[0], P, s, kb_lo, 0, grp, tz);
        swa_blk_load(kv[1], P, s, (1 < nblk - 1) ? kb_lo + 1 : -1, 0, grp, tz);
        __syncthreads();
#pragma unroll 1
        for (int b2 = 0; b2 < nblk; b2 += 2) {
#pragma unroll
          for (int e = 0; e < 2; ++e) {
            const int b = b2 + e; if (b >= nblk) break;
            const int buf = e;
            swa_blk_store(kv[e], F.lds, buf, tz);
            if (b + 2 < nblk) swa_blk_load(kv[e], P, s, (b + 2 < nblk - 1) ? kb_lo + b + 2 : -1, 0, grp, tz);
            __syncthreads();
            const bool ismeta = (b == nblk - 1);
            const int kpos0 = ismeta ? 0 : NMETA + (kb_lo + b) * 64;
            const LAS unsigned char* kb_ = F.lds + SW_KB + buf * SW_BLK;
            const LAS unsigned char* vb_ = F.lds + SW_VB + buf * SW_BLK;
#pragma unroll 1
            for (int h2 = 0; h2 < 2; ++h2) {
                if (ismeta && h2 == 1) continue;
                bf16x8 kf0[4], kf1[4];
#pragma unroll
                for (int kk = 0; kk < 4; ++kk) { kf0[kk] = *(const LAS bf16x8*)(kb_ + (h2 * 32 + i) * 272 + (kk * 32 + 8 * g) * 2); kf1[kk] = *(const LAS bf16x8*)(kb_ + (h2 * 32 + 16 + i) * 272 + (kk * 32 + 8 * g) * 2); }
                bf16x8 vf[8];
#pragma unroll
                for (int dt = 0; dt < 8; ++dt) { const LAS unsigned char* ap = vb_ + (h2 * 32 + 4 * g + (i >> 2)) * 272 + (16 * dt + 4 * (i & 3)) * 2; vf[dt] = cat4(lds_tr(ap), lds_tr(ap + 16 * 272)); }
#pragma unroll
                for (int qt = 0; qt < 2; ++qt) {
                    f32x4 t0 = (f32x4){0.f, 0.f, 0.f, 0.f}, t1 = (f32x4){0.f, 0.f, 0.f, 0.f};
#pragma unroll
                    for (int kk = 0; kk < 4; ++kk) { t0 = mfma16(kf0[kk], qf[qt][kk], t0); t1 = mfma16(kf1[kk], qf[qt][kk], t1); }
                    float m[8]; float ls = 0.f;
                    const float dfl = (float)(kpos0 + h2 * 32 + 4 * g - posq[qt]);
                    const bool edge = (qb < 0 || kb_lo + b <= qb - 2 || kb_lo + b >= qb + 2);
                    if (ismeta) {
#pragma unroll
                        for (int r = 0; r < 4; ++r) { const float p0 = (h2 * 32 + 4 * g + r < NMETA) ? __builtin_amdgcn_exp2f(fminf(t0[r] * scale2, 86.f)) : 0.f; m[r] = p0; m[4 + r] = 0.f; ls += p0; }
                    } else {
#pragma unroll
                        for (int r = 0; r < 4; ++r) { const float x0 = dfl + (float)r, x1 = dfl + (float)(r + 16);
                            float p0 = __builtin_amdgcn_exp2f(fminf(t0[r] * scale2 - slope2 * fabsf(x0), 86.f)), p1 = __builtin_amdgcn_exp2f(fminf(t1[r] * scale2 - slope2 * fabsf(x1), 86.f));
                            if (edge) { p0 = fabsf(x0) <= 128.f ? p0 : 0.f; p1 = fabsf(x1) <= 128.f ? p1 : 0.f; }
                            m[r] = p0; m[4 + r] = p1; ls += p0 + p1; }
                    }
                    lp[qt] += ls;
                    const bf16x8 af = pack8(m);
#pragma unroll
                    for (int dt = 0; dt < 8; ++dt) O[qt][dt] = mfma16(vf[dt], af, O[qt][dt]);
                }
                __builtin_amdgcn_sched_barrier(0);
            }
          }
        }
        const float snk = exp2f(a.in[11][layer * 8 + hq] * LOG2E);
        int lz = F.lane; asm volatile("" : "+v"(lz)); const int g2 = lz >> 4, i2 = lz & 15;
#pragma unroll
        for (int qt = 0; qt < 2; ++qt) {
            float l = lp[qt]; l += __shfl_xor(l, 16); l += __shfl_xor(l, 32); l += snk;
            const float inv = __builtin_amdgcn_rcpf(l);
            const int qi = half * 32 + 16 * qt + i2;
            if (qi < nq) { const int row = qb < 0 ? META0 + s * NMETA + qi : st0 + qb * 64 + qi;
#pragma unroll
                for (int dt = 0; dt < 8; ++dt) { const f32x4 o = O[qt][dt] * inv; *(v2u*)(XN + (size_t)row * D + 1024 + hq * 128 + 16 * dt + 4 * g2) = (v2u){pk2(o[0], o[1]), pk2(o[2], o[3])}; } }
        }
    }
}
constexpr int NA_STG = 36864, NA_V = 18432, NA_RPB = 73728;
__device__ __forceinline__ void na_row_load(v4u (&kv)[4], const bf16* P, int s, int kr, int hp, int tid) {
#pragma unroll
    for (int q = 0; q < 4; ++q) { const int idx = tid + q * NTHREADS, isv = idx >> 10, hd = (idx >> 9) & 1, tok = (idx >> 3) & 63, pc = idx & 7;
        int row; if (kr >= 0) row = seq_start(s) + kr * 64 + tok; else row = tok < NMETA ? META0 + s * NMETA + tok : -1;
        kv[q] = row >= 0 ? *(const v4u*)(P + (size_t)row * P_LD + PC_NA + 1024 * (1 + isv) + (hp * 2 + hd) * 64 + pc * 8) : (v4u){0u, 0u, 0u, 0u}; }
}
__device__ __forceinline__ void na_row_store(const v4u (&kv)[4], LAS unsigned char* lds, int buf, int tid) {
#pragma unroll
    for (int q = 0; q < 4; ++q) { const int idx = tid + q * NTHREADS, isv = idx >> 10, hd = (idx >> 9) & 1, tok = (idx >> 3) & 63, pc = idx & 7;
        *(LAS v4u*)(lds + buf * NA_STG + isv * NA_V + hd * 9216 + tok * 144 + pc * 16) = kv[q]; }
}
__device__ __forceinline__ void na_unit(const Frame& F, KArgs& a, int layer, int u) {
    const bf16* P = (const bf16*)(F.ws + WS_P);
    bf16* XN = (bf16*)(F.ws + WS_XN);
    constexpr float LOG2E = 1.4426950408889634f;
    LAS float* rpbl = (LAS float*)(F.lds + NA_RPB);
    {
        int s, R, hp;
        if (u < 768) { hp = u & 7; const int q4 = u >> 3; if (q4 < 32) { s = q4 >> 4; R = (q4 & 15) * 4; } else { s = 2 + ((q4 - 32) >> 3); R = ((q4 - 32) & 7) * 4; } }
        else { hp = (u - 768) & 7; s = (u - 768) >> 3; R = -1; }
        const int T = seq_T(s), st0 = seq_start(s), nrows = T >> 6;
        int tz = F.tid; asm volatile("" : "+v"(tz));
        const int lane = tz & 63, g = lane >> 4, i = lane & 15;
        const int hd = F.wave >> 2, ct = F.wave & 3, h = hp * 2 + hd;
        int kr_lo, kr_hi;
        if (R >= 0) { int a0 = R - 4; a0 = a0 < 0 ? 0 : (a0 > nrows - 8 ? nrows - 8 : a0); int a1 = R + 3 - 4; a1 = a1 < 0 ? 0 : (a1 > nrows - 8 ? nrows - 8 : a1); kr_lo = a0; kr_hi = a1 + 7; }
        else { kr_lo = 0; kr_hi = 7; }
        const int nst = kr_hi - kr_lo + 2;
        const int c0 = 16 * ct, c = c0 + i;
        int cw = c0 - 8; cw = cw < 0 ? 0 : (cw > 32 ? 32 : cw);
        int cs = c - 8; cs = cs < 0 ? 0 : (cs > 48 ? 48 : cs);
        if (R < 0) { cw = 0; cs = 0; }
        const int nqr = R < 0 ? 1 : 4;
        int boff[8];
#pragma unroll
        for (int r = 0; r < 4; ++r) { const int k0 = cw + 4 * g + r, k1 = k0 + 16; const bool v0 = (k0 >= cs && k0 <= cs + 15), v1 = (k1 >= cs && k1 <= cs + 15);
            boff[r] = v0 ? (R >= 0 ? k0 - c + 15 : 0) : 31; boff[4 + r] = v1 ? (R >= 0 ? k1 - c + 15 : 0) : 31; }
        bf16x8 qf[4][2];
#pragma unroll
        for (int qr = 0; qr < 4; ++qr) { int row;
            if (R >= 0) row = st0 + (R + qr) * 64 + c; else row = META0 + s * NMETA + i;
#pragma unroll
            for (int kk = 0; kk < 2; ++kk) qf[qr][kk] = *(const bf16x8*)(P + (size_t)row * P_LD + PC_NA + h * 64 + kk * 32 + 8 * g); }
        f32x4 O[4][4]; float lp[4] = {0.f, 0.f, 0.f, 0.f};
#pragma unroll
        for (int qr = 0; qr < 4; ++qr)
#pragma unroll
            for (int dt = 0; dt < 4; ++dt) O[qr][dt] = (f32x4){0.f, 0.f, 0.f, 0.f};
        v4u kv[2][4];
        na_row_load(kv[0], P, s, kr_lo, hp, tz);
        na_row_load(kv[1], P, s, (1 < nst - 1) ? kr_lo + 1 : -1, hp, tz);
        __syncthreads();
        for (int e = tz; e < 2 * 512; e += NTHREADS) { const int hd2 = e >> 9, ro = (e >> 5) & 15, col = e & 31;
            rpbl[e] = col == 31 ? -1e30f : (ro < 15 ? a.in[12][((size_t)layer * 16 + hp * 2 + hd2) * 465 + ro * 31 + col] * LOG2E : 0.f); }
#pragma unroll 1
        for (int b2 = 0; b2 < nst; b2 += 2) {
#pragma unroll
          for (int e = 0; e < 2; ++e) {
            const int b = b2 + e; if (b >= nst) break;
            const int buf = e;
            na_row_store(kv[e], F.lds, buf, tz);
            if (b + 2 < nst) na_row_load(kv[e], P, s, (b + 2 < nst - 1) ? kr_lo + b + 2 : -1, hp, tz);
            __syncthreads();
            const bool ismeta = (b == nst - 1);
            const int kr = kr_lo + b;
            const LAS unsigned char* kb_ = F.lds + buf * NA_STG + hd * 9216;
            const LAS unsigned char* vb_ = kb_ + NA_V;
            const int kc0 = ismeta ? 0 : cw;
            bf16x8 kf0[2], kf1[2];
#pragma unroll
            for (int kk = 0; kk < 2; ++kk) { kf0[kk] = *(const LAS bf16x8*)(kb_ + (kc0 + i) * 144 + (kk * 32 + 8 * g) * 2); kf1[kk] = *(const LAS bf16x8*)(kb_ + (kc0 + 16 + i) * 144 + (kk * 32 + 8 * g) * 2); }
            bf16x8 vf[4];
#pragma unroll
            for (int dt = 0; dt < 4; ++dt) { const LAS unsigned char* ap = vb_ + (kc0 + 4 * g + (i >> 2)) * 144 + (16 * dt + 4 * (i & 3)) * 2; vf[dt] = cat4(lds_tr(ap), lds_tr(ap + 16 * 144)); }
#pragma unroll
            for (int qr = 0; qr < 4; ++qr) {
                if (qr >= nqr) continue;
                int r0 = 0, roff = 15;
                if (R >= 0) { r0 = R + qr - 4; r0 = r0 < 0 ? 0 : (r0 > nrows - 8 ? nrows - 8 : r0); roff = kr - (R + qr) + 7; }
                if (!ismeta && (kr < r0 || kr > r0 + 7)) continue;
                f32x4 t0 = (f32x4){0.f, 0.f, 0.f, 0.f}, t1 = (f32x4){0.f, 0.f, 0.f, 0.f};
#pragma unroll
                for (int kk = 0; kk < 2; ++kk) { t0 = mfma16(kf0[kk], qf[qr][kk], t0); t1 = mfma16(kf1[kk], qf[qr][kk], t1); }
                float m[8]; float ls = 0.f;
                if (ismeta) {
#pragma unroll
                    for (int r = 0; r < 4; ++r) { const float p0 = (4 * g + r < NMETA) ? __builtin_amdgcn_exp2f(fminf(t0[r] * (0.125f * LOG2E), 86.f)) : 0.f; m[r] = p0; m[4 + r] = 0.f; ls += p0; }
                } else {
                    const LAS float* bp = rpbl + hd * 512 + roff * 32;
#pragma unroll
                    for (int r = 0; r < 4; ++r) {
                        const float b0 = bp[boff[r]], b1 = bp[boff[4 + r]];
                        const float a0 = t0[r] * (0.125f * LOG2E) + b0, a1 = t1[r] * (0.125f * LOG2E) + b1;
                        const float p0 = __builtin_amdgcn_exp2f(fminf(a0, 86.f)), p1 = __builtin_amdgcn_exp2f(fminf(a1, 86.f));
                        m[r] = p0; m[4 + r] = p1; ls += p0 + p1;
                    }
                }
                lp[qr] += ls;
                const bf16x8 af = pack8(m);
#pragma unroll
                for (int dt = 0; dt < 4; ++dt) O[qr][dt] = mfma16(vf[dt], af, O[qr][dt]);
            }
            __builtin_amdgcn_sched_barrier(0);
          }
        }
        int lz = F.lane; asm volatile("" : "+v"(lz)); const int g2 = lz >> 4, i2 = lz & 15;
#pragma unroll
        for (int qr = 0; qr < 4; ++qr) {
            if (qr >= nqr) continue;
            float l = lp[qr]; l += __shfl_xor(l, 16); l += __shfl_xor(l, 32);
            const float inv = __builtin_amdgcn_rcpf(l);
            int row; bool ok = true;
            if (R >= 0) row = st0 + (R + qr) * 64 + c0 + i2; else { row = META0 + s * NMETA + i2; ok = (ct == 0); }
            if (ok) {
#pragma unroll
                for (int dt = 0; dt < 4; ++dt) { const f32x4 o = O[qr][dt] * inv; *(v2u*)(XN + (size_t)row * D + 2048 + h * 64 + 16 * dt + 4 * g2) = (v2u){pk2(o[0], o[1]), pk2(o[2], o[3])}; } }
        }
    }
}
__device__ __forceinline__ void p_attn(const Frame& F, KArgs& a, int layer) {
    const int NBG = bg_entries(0, layer);
    DYN_LOOP_BEGIN(q, 1636 + NBG, layer * 4 + 0)
        int u; const int be = bg_split(q, 1636, NBG, u);
        if (be >= 0) { bg_entry(F, a, 0, layer, be); } else {
        int su = -1, nu = -1;
        if (u < 768) su = u; else if (u < 1536) nu = u - 768; else if (u < 1556) su = 768 + (u - 1536); else nu = 768 + (u - 1556);
        if (su >= 0) swa_unit(F, a, layer, su); else na_unit(F, a, layer, nu);
        }
    DYN_LOOP_END(q)
    __syncthreads();
}

constexpr int N_PHASES = 22;
__global__ void __launch_bounds__(NTHREADS, 2) fwd_kernel(Args args_v) {
    extern __shared__ __attribute__((aligned(16))) unsigned char lds[];
#define MKFRAME() Frame F; F.lds = (LAS unsigned char*)lds; F.tid = opaque_tid(wave_s); F.lane = F.tid & 63; F.wave = __builtin_amdgcn_readfirstlane(F.tid >> 6); \
    F.G = gridDim.x; F.gw = blockIdx.x * NWAVES + F.wave; F.NGW = F.G * NWAVES; KArgs* kap = (KArgs*)__builtin_amdgcn_kernarg_segment_ptr(); asm volatile("" : "+s"(kap)); KArgs& args = *kap; F.ws = args.ws; F.out = args.out
    LAS unsigned char* const ldsp = (LAS unsigned char*)lds;
#define GEMM_PTRS() KArgs* kap = (KArgs*)__builtin_amdgcn_kernarg_segment_ptr(); asm volatile("" : "+s"(kap)); unsigned char* ws = kap->ws; float* outp = kap->out; (void)outp
    const int wave_s = __builtin_amdgcn_readfirstlane((int)threadIdx.x >> 6);
    volatile LAS unsigned* MISC = (volatile LAS unsigned*)(ldsp + MISC_OFF);
    for (int u = threadIdx.x; u < (LDS_BYTES - LDSCTL_OFF) / 4; u += NTHREADS) ((LAS unsigned*)(ldsp + LDSCTL_OFF))[u] = 0u;
    __syncthreads();
    unsigned* ctl = (unsigned*)(args_v.ws + WS_CTL);
    const bool multi = (args_v.ph_hi - args_v.ph_lo) > 1;
    if (multi) {
        XcdBarrier bar = xcd_barrier_post(ctl + CW_BAR, MISC + 8);
        if (threadIdx.x == 0) { unsigned nloc, nx; xcd_barrier_complete(ctl + CW_BAR, bar.x, nloc, nx); MISC[8] = nloc; MISC[9] = nx; }
        __syncthreads();
    }
#ifndef PHMASK
#define PHMASK 0xFFF
#endif
#define PHM(k) ((PHMASK >> ((k) == 0 ? 0 : ((k) == 21 ? 11 : (((k) - 1) % 10) + 1))) & 1)
#define KAP_() ((KArgs*)__builtin_amdgcn_kernarg_segment_ptr())
#define IN(k) (PHM(k) && KAP_()->ph_lo <= (k) && (k) < KAP_()->ph_hi)
#define BAR_() do { XcdBarrier b_; b_.bar = (unsigned*)(KAP_()->ws + WS_CTL) + CW_BAR; b_.x = xb_xcc_id(); b_.st = (volatile LAS unsigned*)((LAS unsigned char*)lds + MISC_OFF) + 8; xcd_barrier(b_, wave_s == 0 && opaque_lane() == 0); } while (0)
#define SEAM(k) do { if (IN(k) && IN((k) + 1)) BAR_(); } while (0)
#ifndef REPMASK
#define REPMASK 0
#endif
#define REPM(k) ((REPMASK >> ((k) == 0 ? 0 : ((k) == 21 ? 11 : (((k) - 1) % 10) + 1))) & 1)
#define RUN2(k, body) do { { body; } if (REPM(k)) { BAR_(); { body; } } } while (0)
    if (IN(0)) { RUN2(0, MKFRAME(); p_prologue(F, args)); SEAM(0); }
#define LAYER_BODY(layer) do { \
        const int pb = 1 + 10 * layer; \
        if (IN(pb + 0)) { if (layer > 0) { MKFRAME(); p_norm_meta(F, 2 * layer); SEAM(pb + 0); } } \
        if (IN(pb + 1)) { \
            GEMM_PTRS(); \
            pg8::Gemm g{(const bf16*)(ws + WS_HB), (const bf16*)(ws + WS_WIN + layer * SZ_WIN), MP, IN_N, D}; \
            pg8::StaticOrder S; S.init(IN_N, D, 1, (int)gridDim.x, (int)blockIdx.x); \
            pg8::EpiInProj E{(bf16*)(ws + WS_P), (float*)(ws + WS_DT), (const float*)(ws + WS_RSTD) + (size_t)(2 * layer) * MP}; \
            RUN2(pb + 1, (pg8::gemm_phase<pg8::EpiInProj, pg8::StaticOrder, true, true>(ldsp + RING_OFF, g, S, E, wave_s))); \
            SEAM(pb + 1); \
        } \
        if (IN(pb + 2)) { RUN2(pb + 2, { MKFRAME(); p_ssd_prep(F, args, layer); } { MKFRAME(); p_attn(F, args, layer); }); SEAM(pb + 2); } \
        if (IN(pb + 3)) { RUN2(pb + 3, MKFRAME(); p_scanA(F, args, layer)); SEAM(pb + 3); } \
        if (IN(pb + 4)) { RUN2(pb + 4, MKFRAME(); p_scanB(F, args)); SEAM(pb + 4); } \
        if (IN(pb + 5)) { RUN2(pb + 5, MKFRAME(); p_scanC(F, args, layer)); SEAM(pb + 5); } \
        if (IN(pb + 6)) { \
            GEMM_PTRS(); \
            pg8::Gemm g{(const bf16*)(ws + WS_XN), (const bf16*)(ws + WS_WOUT + layer * SZ_WOUT), MP, D, D}; \
            pg8::StaticOrder S; S.init(D, D, 16, (int)gridDim.x, (int)blockIdx.x); \
            pg8::EpiResid E{(bf16*)(ws + WS_HB), (float*)(ws + WS_SLAB), D / 64, (float*)(ws + WS_SSP), nullptr}; \
            pg8::gemm_phase<pg8::EpiResid, pg8::StaticOrder, true, true>(ldsp + RING_OFF, g, S, E, wave_s); \
            SEAM(pb + 6); \
        } \
        if (IN(pb + 7)) { MKFRAME(); p_norm_meta(F, 2 * layer + 1); SEAM(pb + 7); } \
        if (IN(pb + 8)) { \
            GEMM_PTRS(); \
            pg8::Gemm g{(const bf16*)(ws + WS_HB), (const bf16*)(ws + WS_WUP + layer * SZ_WUP), MP, FF, D}; \
            pg8::StaticOrder S; S.init(FF, D, 1, (int)gridDim.x, (int)blockIdx.x); \
            pg8::EpiUp E{(bf16*)(ws + WS_HID), (const float*)(ws + WS_RSTD) + (size_t)(2 * layer + 1) * MP}; \
            RUN2(pb + 8, (pg8::gemm_phase<pg8::EpiUp, pg8::StaticOrder, true, true>(ldsp + RING_OFF, g, S, E, wave_s))); \
            SEAM(pb + 8); \
        } \
        if (IN(pb + 9)) { \
            GEMM_PTRS(); \
            pg8::Gemm g{(const bf16*)(ws + WS_HID), (const bf16*)(ws + WS_WDN + layer * SZ_WDN), MP, D, FF}; \
            pg8::StaticOrder S; S.init(D, FF, 16, (int)gridDim.x, (int)blockIdx.x); \
            pg8::EpiResid E{(bf16*)(ws + WS_HB), (float*)(ws + WS_SLAB), FF / 64, (float*)(ws + WS_SSP), nullptr}; \
            pg8::gemm_phase<pg8::EpiResid, pg8::StaticOrder, true, true>(ldsp + RING_OFF, g, S, E, wave_s); \
            SEAM(pb + 9); \
        } \
     \
    } while (0)
    LAYER_BODY(0);
    LAYER_BODY(1);
#undef LAYER_BODY
    if (IN(21)) { MKFRAME(); p_final_norm(F, args); }
#undef IN
#undef SEAM
}

extern "C" void kernel_launch(void* const* d_in, const int* in_sizes, int n_in, void* d_out, int out_size, void* d_ws, size_t ws_size, hipStream_t stream) {
    static int grid = 0;
    if (grid == 0) {
        if (n_in != 19 || ws_size < WS_END) { fprintf(stderr, "kernel_launch: unexpected shapes (n_in %d, ws %zu, need %zu)\n", n_in, ws_size, (size_t)WS_END); grid = -1; return; }
        int dev = 0, cus = 0, per_cu = 0;
        if (hipGetDevice(&dev) != hipSuccess || hipDeviceGetAttribute(&cus, hipDeviceAttributeMultiprocessorCount, dev) != hipSuccess) { grid = -1; return; }
        if (hipFuncSetAttribute((const void*)fwd_kernel, hipFuncAttributeMaxDynamicSharedMemorySize, LDS_BYTES) != hipSuccess) { fprintf(stderr, "kernel_launch: hipFuncSetAttribute failed\n"); grid = -1; return; }
        if (hipOccupancyMaxActiveBlocksPerMultiprocessor(&per_cu, (const void*)fwd_kernel, NTHREADS, LDS_BYTES) != hipSuccess || per_cu < 1) { fprintf(stderr, "kernel_launch: occupancy query says %d\n", per_cu); }
        (void)hipGetLastError();
        grid = cus;
    }
    if (grid < 0) return;
    (void)hipMemsetAsync((char*)d_ws + WS_CTL, 0, CTL_ZERO_BYTES, stream);
    Args a{};
    for (int i = 0; i < 19; ++i) a.in[i] = (const float*)d_in[i];
    a.out = (float*)d_out; a.ws = (unsigned char*)d_ws;
#if N_LAUNCH_MODE == 1
    a.ph_lo = 0; a.ph_hi = N_PHASES;
    hipLaunchKernelGGL(fwd_kernel, dim3(grid), dim3(NTHREADS), LDS_BYTES, stream, a);
#else
    for (int ph = 0; ph < N_PHASES; ++ph) {
        a.ph_lo = ph; a.ph_hi = ph + 1;
        hipLaunchKernelGGL(fwd_kernel, dim3(grid), dim3(NTHREADS), LDS_BYTES, stream, a);
    }
#endif
}
```
